# Optimizing an MI355X kernel written in HIP

```python
import jax, jax.numpy as jnp
from jax import lax
import numpy as np

D_MODEL = 1024
BATCH = 4
SEQ = 4096
DEPTH = 4

HEAD_DIM = 64
N_MEM = 256
MEM_HEADS = 4
CROSS_WIDTH = MEM_HEADS * HEAD_DIM
MIX_WIDTH = 12 * HEAD_DIM
ATTN_WIDTH = MIX_WIDTH + CROSS_WIDTH
EPS = 1e-6
NEG = -1e30
MLA_HEADS = 12
MLA_Q_RANK = 384
MLA_KV_RANK = 256
MLA_NOPE = 64
MLA_ROPE = 32
MLA_V = 64
MLA_QK = MLA_NOPE + MLA_ROPE
ROPE_THETA = 10000.0
Q_BLOCK = 128
MLA_IN = MLA_Q_RANK + MLA_KV_RANK + MLA_ROPE + CROSS_WIDTH
SWA_Q_HEADS = 12
SWA_KV_HEADS = 4
SWA_GROUP = SWA_Q_HEADS // SWA_KV_HEADS
WINDOW = 128
SWA_IN = (SWA_Q_HEADS + 2 * SWA_KV_HEADS) * HEAD_DIM + CROSS_WIDTH
D_FF = 4 * D_MODEL
N_MLA_LAYERS = (DEPTH + 1) // 2
N_SWA_LAYERS = DEPTH // 2

kernel_name = "hybrid_mla_swa_sink_memx_sqrelu"


def rmsnorm(x, g):
    xf = x.astype(jnp.float32)
    y = xf * lax.rsqrt(jnp.mean(xf * xf, axis=-1, keepdims=True) + EPS)
    return (y * g.astype(jnp.float32)).astype(x.dtype)


def rope(x, positions):
    r = x.shape[-1]
    half = r // 2
    inv = ROPE_THETA ** (-(jnp.arange(half, dtype=jnp.float32) * 2.0) / r)
    ang = positions.astype(jnp.float32)[..., None] * inv
    cos = jnp.cos(ang)[:, :, None, :]
    sin = jnp.sin(ang)[:, :, None, :]
    xf = x.astype(jnp.float32)
    x1, x2 = xf[..., :half], xf[..., half:]
    out = jnp.concatenate([x1 * cos - x2 * sin, x1 * sin + x2 * cos], axis=-1)
    return out.astype(x.dtype)


def alibi_slopes(n_heads):
    return 2.0 ** (-8.0 * (jnp.arange(n_heads, dtype=jnp.float32) + 1.0) / n_heads)


def causal_dense_attention(q, k, v):
    b, s, h, dk = q.shape
    dv = v.shape[-1]
    nb = s // Q_BLOCK
    scale = dk ** -0.5
    qb = q.reshape(b, nb, Q_BLOCK, h, dk).transpose(1, 0, 2, 3, 4)
    k_idx = jnp.arange(s)

    def one_block(args):
        q_blk, n = args
        t_idx = n * Q_BLOCK + jnp.arange(Q_BLOCK)
        sc = jnp.einsum('bqhd,bkhd->bhqk', q_blk, k,
                        preferred_element_type=jnp.float32) * scale
        mask = k_idx[None, :] <= t_idx[:, None]
        sc = jnp.where(mask[None, None], sc, NEG)
        p = jax.nn.softmax(sc, axis=-1).astype(v.dtype)
        return jnp.einsum('bhqk,bkhd->bqhd', p, v)

    out = lax.map(one_block, (qb, jnp.arange(nb)))
    return out.transpose(1, 0, 2, 3, 4).reshape(b, s, h, dv)


def mla_mixer(hn, positions, w_in, q_norm_g, kv_norm_g, w_uq, w_ukv):
    b, s, _ = hn.shape
    proj = hn @ w_in
    c_q = proj[..., :MLA_Q_RANK]
    c_kv = proj[..., MLA_Q_RANK:MLA_Q_RANK + MLA_KV_RANK]
    k_r = proj[..., MLA_Q_RANK + MLA_KV_RANK:MLA_Q_RANK + MLA_KV_RANK + MLA_ROPE]
    q_cross = proj[..., MLA_Q_RANK + MLA_KV_RANK + MLA_ROPE:]
    q = (rmsnorm(c_q, q_norm_g) @ w_uq).reshape(b, s, MLA_HEADS, MLA_QK)
    q = jnp.concatenate([q[..., :MLA_NOPE], rope(q[..., MLA_NOPE:], positions)], axis=-1)
    kv = (rmsnorm(c_kv, kv_norm_g) @ w_ukv).reshape(b, s, MLA_HEADS, MLA_NOPE + MLA_V)
    k_nope, v = kv[..., :MLA_NOPE], kv[..., MLA_NOPE:]
    k_rope = jnp.broadcast_to(rope(k_r[:, :, None, :], positions),
                              (b, s, MLA_HEADS, MLA_ROPE))
    k = jnp.concatenate([k_nope, k_rope], axis=-1)
    o = causal_dense_attention(q, k, v)
    return o.reshape(b, s, MLA_HEADS * MLA_V), q_cross


def _with_prev_block(a):
    pad = [(0, 0), (1, 0)] + [(0, 0)] * (a.ndim - 2)
    prev = jnp.pad(a[:, :-1], pad)
    return jnp.concatenate([prev, a], axis=2)


def swa_mixer(hn, positions, w_in, sinks):
    b, s, _ = hn.shape
    nb = s // WINDOW
    proj = hn @ w_in
    nq = SWA_Q_HEADS * HEAD_DIM
    nk = SWA_KV_HEADS * HEAD_DIM
    q = proj[..., :nq].reshape(b, nb, WINDOW, SWA_KV_HEADS, SWA_GROUP, HEAD_DIM)
    k = proj[..., nq:nq + nk].reshape(b, nb, WINDOW, SWA_KV_HEADS, HEAD_DIM)
    v = proj[..., nq + nk:nq + 2 * nk].reshape(b, nb, WINDOW, SWA_KV_HEADS, HEAD_DIM)
    q_cross = proj[..., nq + 2 * nk:]
    kk = _with_prev_block(k)
    vv = _with_prev_block(v)
    pos_q = positions.reshape(b, nb, WINDOW)
    pos_k = _with_prev_block(pos_q)
    sc = jnp.einsum('bnqhgd,bnkhd->bnhgqk', q, kk,
                    preferred_element_type=jnp.float32) * (HEAD_DIM ** -0.5)
    dist = (pos_q[..., :, None] - pos_k[..., None, :]).astype(jnp.float32)
    slopes = alibi_slopes(SWA_Q_HEADS).reshape(SWA_KV_HEADS, SWA_GROUP)
    sc = sc - slopes[None, None, :, :, None, None] * dist[:, :, None, None]
    qi = jnp.arange(WINDOW)[:, None]
    kj = jnp.arange(2 * WINDOW)[None, :]
    rel = WINDOW + qi - kj
    band = (rel >= 0) & (rel < WINDOW)
    valid = band[None] & ((jnp.arange(nb)[:, None, None] > 0) | (kj >= WINDOW)[None])
    sc = jnp.where(valid[None, :, None, None], sc, NEG)
    sink = sinks.astype(jnp.float32).reshape(SWA_KV_HEADS, SWA_GROUP)[None, None, :, :, None, None]
    sink = jnp.broadcast_to(sink, sc.shape[:-1] + (1,))
    p = jax.nn.softmax(jnp.concatenate([sc, sink], axis=-1), axis=-1)[..., :-1]
    o = jnp.einsum('bnhgqk,bnkhd->bnqhgd', p.astype(vv.dtype), vv)
    return o.reshape(b, s, SWA_Q_HEADS * HEAD_DIM), q_cross


def memory_cross_attention(q_cross, mem_n, w_mem_kv):
    b, s, _ = q_cross.shape
    kv = (mem_n @ w_mem_kv).reshape(b, N_MEM, 2, MEM_HEADS, HEAD_DIM)
    k, v = kv[:, :, 0], kv[:, :, 1]
    q = q_cross.reshape(b, s, MEM_HEADS, HEAD_DIM)
    sc = jnp.einsum('bshd,bmhd->bhsm', q, k,
                    preferred_element_type=jnp.float32) * (HEAD_DIM ** -0.5)
    p = jax.nn.softmax(sc, axis=-1).astype(v.dtype)
    return jnp.einsum('bhsm,bmhd->bshd', p, v).reshape(b, s, CROSS_WIDTH)


def squared_relu_mlp(h, w_up, w_down):
    a = jax.nn.relu(h @ w_up)
    return (a * a) @ w_down


def setup_inputs(seed: int = 0) -> dict:
    key = jax.random.key(seed)
    ks = jax.random.split(key, 20)

    def w(k, shape, fan_in):
        return jax.random.normal(k, shape, jnp.float32) * (fan_in ** -0.5)

    def gain(k, shape):
        return 1.0 + 0.02 * jax.random.normal(k, shape, jnp.float32)

    x = jax.random.normal(ks[0], (BATCH, SEQ, D_MODEL), jnp.float32)
    mem = jax.random.normal(ks[1], (BATCH, N_MEM, D_MODEL), jnp.float32)
    offsets = jax.random.randint(ks[2], (BATCH, 1), 0, 1024, dtype=jnp.int32)
    positions = (offsets + jnp.arange(SEQ, dtype=jnp.int32)[None, :]).astype(jnp.int32)
    return {
        "x": x,
        "mem": mem,
        "positions": positions,
        "attn_norm_g": gain(ks[3], (DEPTH, D_MODEL)),
        "mlp_norm_g": gain(ks[4], (DEPTH, D_MODEL)),
        "mem_norm_g": gain(ks[5], (D_MODEL,)),
        "final_norm_g": gain(ks[6], (D_MODEL,)),
        "mla_w_in": w(ks[7], (N_MLA_LAYERS, D_MODEL, MLA_IN), D_MODEL),
        "mla_q_norm_g": gain(ks[8], (N_MLA_LAYERS, MLA_Q_RANK)),
        "mla_kv_norm_g": gain(ks[9], (N_MLA_LAYERS, MLA_KV_RANK)),
        "mla_w_uq": w(ks[10], (N_MLA_LAYERS, MLA_Q_RANK, MLA_HEADS * MLA_QK), MLA_Q_RANK),
        "mla_w_ukv": w(ks[11], (N_MLA_LAYERS, MLA_KV_RANK, MLA_HEADS * (MLA_NOPE + MLA_V)), MLA_KV_RANK),
        "swa_w_in": w(ks[12], (N_SWA_LAYERS, D_MODEL, SWA_IN), D_MODEL),
        "swa_sinks": 0.5 * jax.random.normal(ks[13], (N_SWA_LAYERS, SWA_Q_HEADS), jnp.float32),
        "w_mem_kv": w(ks[14], (DEPTH, D_MODEL, 2 * CROSS_WIDTH), D_MODEL),
        "w_o": w(ks[15], (DEPTH, ATTN_WIDTH, D_MODEL), ATTN_WIDTH),
        "mlp_w_up": w(ks[16], (DEPTH, D_MODEL, D_FF), D_MODEL),
        "mlp_w_down": w(ks[17], (DEPTH, D_FF, D_MODEL), D_FF),
    }


def reference(x, mem, positions, attn_norm_g, mlp_norm_g, mem_norm_g, final_norm_g,
              mla_w_in, mla_q_norm_g, mla_kv_norm_g, mla_w_uq, mla_w_ukv,
              swa_w_in, swa_sinks, w_mem_kv, w_o, mlp_w_up, mlp_w_down):
    mem_n = rmsnorm(mem, mem_norm_g)
    for i in range(DEPTH):
        j = i // 2
        hn = rmsnorm(x, attn_norm_g[i])
        if i % 2 == 0:
            mix, q_cross = mla_mixer(hn, positions, mla_w_in[j], mla_q_norm_g[j],
                                     mla_kv_norm_g[j], mla_w_uq[j], mla_w_ukv[j])
        else:
            mix, q_cross = swa_mixer(hn, positions, swa_w_in[j], swa_sinks[j])
        cross = memory_cross_attention(q_cross, mem_n, w_mem_kv[i])
        x = x + jnp.concatenate([mix, cross], axis=-1) @ w_o[i]
        x = x + squared_relu_mlp(rmsnorm(x, mlp_norm_g[i]), mlp_w_up[i], mlp_w_down[i])
    return rmsnorm(x, final_norm_g)
```

```cpp
#include <hip/hip_runtime.h>
#include <cstdio>
#include <cstdint>

#ifndef MK_PER_PHASE_LAUNCH
#define MK_PER_PHASE_LAUNCH 0
#endif

#define LAS __attribute__((address_space(3)))
#define GAS __attribute__((address_space(1)))
typedef unsigned short bf16_t;
typedef short bf16x8 __attribute__((ext_vector_type(8)));
typedef short s16x4 __attribute__((ext_vector_type(4)));
typedef float f32x2 __attribute__((ext_vector_type(2)));
typedef float f32x4 __attribute__((ext_vector_type(4)));
typedef float f32x16 __attribute__((ext_vector_type(16)));
typedef unsigned u32x2 __attribute__((ext_vector_type(2)));
typedef unsigned u32x4 __attribute__((ext_vector_type(4)));
typedef __bf16 bf16x2_t __attribute__((ext_vector_type(2)));

constexpr int NB = 4, S = 4096, T = NB * S, D = 1024, FF = 4096, NMEM = 256, DEPTH = 4;
constexpr int PROJ_LD = 1280;
constexpr int QLD = 1280;
constexpr float EPS = 1e-6f;
constexpr float LOG2E = 1.4426950408889634f;

constexpr size_t MiB = 1u << 20;
constexpr size_t WS_CTL = 0, CTL_ZERO_BYTES = 1 * MiB;
constexpr size_t WS_COS = 1 * MiB, WS_SIN = 2 * MiB;
constexpr size_t WS_MEMN = 3 * MiB;
constexpr size_t WS_MEMK = 5 * MiB, WS_MEMVT = 5 * MiB + 512 * 1024;
constexpr size_t WS_W_IN = 6 * MiB;
constexpr size_t WS_W_UQ = 9 * MiB;
constexpr size_t WS_W_UK = 10 * MiB, WS_W_UV = 10 * MiB + 512 * 1024;
constexpr size_t WS_W_V = 11 * MiB;
constexpr size_t WS_W_MK = 11 * MiB + 512 * 1024, WS_W_MV = 12 * MiB;
constexpr size_t WS_W_O = 13 * MiB;
constexpr size_t WS_W_UP = 15 * MiB;
constexpr size_t WS_W_DN = 23 * MiB;
constexpr size_t WS_HN = 32 * MiB;
constexpr size_t WS_ABUF = 64 * MiB;
constexpr size_t WS_PROJ = 64 * MiB;
constexpr size_t WS_Q = 104 * MiB;
constexpr size_t WS_KN = 144 * MiB;
constexpr size_t WS_VT = 168 * MiB;
constexpr size_t WS_ATT = 192 * MiB;
constexpr size_t WS_CQN = 224 * MiB;
constexpr size_t WS_CKVN = 236 * MiB;
constexpr size_t WS_KROPE = 244 * MiB;
constexpr size_t WS_END = 245 * MiB;
constexpr int CW_BAR = 4096;

constexpr int RING_BYTES = 131072;
constexpr int LDSCTL_OFF = RING_BYTES, MISC_OFF = LDSCTL_OFF + 320;
constexpr int LDS_BYTES = 147456;
constexpr int NWAVES = 8;

__device__ const float rope_inv[16] = {1.0f, 0.5623413251903491f, 0.31622776601683794f, 0.1778279410038923f, 0.1f, 0.05623413251903491f,
    0.03162277660168379f, 0.01778279410038923f, 0.01f, 0.005623413251903491f, 0.0031622776601683794f, 0.0017782794100389228f, 0.001f,
    0.0005623413251903491f, 0.00031622776601683794f, 0.00017782794100389227f};

__device__ __forceinline__ unsigned f2bf(float f) { unsigned u = __builtin_bit_cast(unsigned, f); return (u + 0x7fffu + ((u >> 16) & 1u)) >> 16; }
__device__ __forceinline__ unsigned pk2(float lo, float hi) { return f2bf(lo) | (f2bf(hi) << 16); }
__device__ __forceinline__ float bf2f(unsigned b) { return __builtin_bit_cast(float, b << 16); }
__device__ __forceinline__ unsigned cvtpk(float lo, float hi) { f32x2 v = {lo, hi}; bf16x2_t b = __builtin_convertvector(v, bf16x2_t); return __builtin_bit_cast(unsigned, b); }
#define LDS_WAIT() asm volatile("s_waitcnt lgkmcnt(0)" ::: "memory")
#define VM_WAIT() asm volatile("s_waitcnt vmcnt(0)" ::: "memory")

namespace pg8 {
constexpr int BM = 256, BK = 64, HALF = 128, HTB = HALF * BK * 2, STAGE_BYTES = 8 * HTB, NXCD = 8, WGM = 8;
__host__ __device__ __forceinline__ int lds_byte(int r, int c) { const int st = (r >> 4) * 2 + (c >> 5), rr = r & 15, cc = c & 31, ob = rr * 64 + cc * 2; return st * 1024 + (ob ^ (((ob >> 9) & 1) << 5)); }
__host__ __device__ __forceinline__ void stage_rc(int b, int& R, int& C) { const int st = b / 1024, sb = b % 1024, swz = sb ^ (((sb >> 9) & 1) << 5); R = (st >> 1) * 16 + swz / 64; C = (st & 1) * 32 + (swz % 64) / 2; }
__host__ __device__ __forceinline__ int perm32(int rho) { const int n = rho >> 4, i = rho & 15; return 8 * (i >> 2) + 4 * n + (i & 3); }

struct Unit { int pm, pn; };
struct Gemm { const bf16_t* A; const bf16_t* Bt; int M, N, K, lda, ldb; };

struct StaticOrder {
    int nM, nN, nwg, G, c;
    __device__ void init(int M, int N, int G_, int c_, int rot) { nM = M / BM; nN = N / BM; nwg = nM * nN; G = G_; c = (c_ + G_ - (rot % G_)) % G_; }
    __device__ bool next(int i, Unit& u) const {
        const long L = (long)i * G + c; if (L >= nwg) return false;
        int wgid = (int)L; { const int q = nwg / NXCD, r = nwg % NXCD, xcd = wgid % NXCD, off = wgid / NXCD; wgid = (xcd < r ? xcd * (q + 1) : r * (q + 1) + (xcd - r) * q) + off; }
        const int nig = WGM * nN, gid = wgid / nig, fm = gid * WGM, gsz = (nM - fm) < WGM ? (nM - fm) : WGM;
        u.pm = fm + ((wgid % nig) % gsz); u.pn = (wgid % nig) / gsz; return true;
    }
};

__device__ __forceinline__ unsigned cvt_pk_bf16(float lo, float hi) { unsigned r; asm volatile("v_cvt_pk_bf16_f32 %0, %1, %2" : "=v"(r) : "v"(lo), "v"(hi)); return r; }

template <int ACT  > struct EpiBf16 {
    static constexpr bool PERM = true;
    bf16_t* O; int ldc;
    __device__ __forceinline__ void operator()(const f32x4 (&acc)[2][2][4][2], const Unit& u, int wr, int wc, int fr, int fq) const {
        const int row0 = u.pm * BM + wr * 64 + fr; const int col0 = u.pn * BM + wc * 32 + 8 * fq;
#pragma unroll
        for (int ai = 0; ai < 2; ++ai)
#pragma unroll
            for (int m = 0; m < 4; ++m) { bf16_t* rowp = O + (size_t)(row0 + ai * HALF + m * 16) * ldc + col0;
#pragma unroll
                for (int bj = 0; bj < 2; ++bj) { f32x4 v0 = acc[ai][bj][m][0], v1 = acc[ai][bj][m][1];
                    if (ACT == 1) {
#pragma unroll
                        for (int e = 0; e < 4; ++e) { const float a = fmaxf(v0[e], 0.f), b = fmaxf(v1[e], 0.f); v0[e] = a * a; v1[e] = b * b; } }
                    u32x4 w; w.x = cvt_pk_bf16(v0[0], v0[1]); w.y = cvt_pk_bf16(v0[2], v0[3]); w.z = cvt_pk_bf16(v1[0], v1[1]); w.w = cvt_pk_bf16(v1[2], v1[3]);
                    *(u32x4*)(rowp + bj * HALF) = w; } }
    }
};
struct EpiRes {
    static constexpr bool PERM = false;
    const float* base; float* out; int ldc;
    __device__ __forceinline__ void operator()(const f32x4 (&acc)[2][2][4][2], const Unit& u, int wr, int wc, int fr, int fq) const {
        const int row0 = u.pm * BM + wr * 64 + fr, col0 = u.pn * BM + wc * 32 + 4 * fq;
#pragma unroll
        for (int ai = 0; ai < 2; ++ai)
#pragma unroll
            for (int m = 0; m < 4; ++m) { const size_t off = (size_t)(row0 + ai * HALF + m * 16) * ldc + col0;
#pragma unroll
                for (int bj = 0; bj < 2; ++bj)
#pragma unroll
                    for (int n = 0; n < 2; ++n) { const f32x4 b = *(const f32x4*)(base + off + bj * HALF + n * 16); *(f32x4*)(out + off + bj * HALF + n * 16) = b + acc[ai][bj][m][n]; } }
    }
};
struct EpiRope {
    static constexpr bool PERM = false;
    bf16_t* O; int ldc; const float* cs; const float* sn;
    __device__ __forceinline__ void operator()(const f32x4 (&acc)[2][2][4][2], const Unit& u, int wr, int wc, int fr, int fq) const {
        const int row0 = u.pm * BM + wr * 64 + fr;
#pragma unroll
        for (int ai = 0; ai < 2; ++ai)
#pragma unroll
            for (int m = 0; m < 4; ++m) { const int row = row0 + ai * HALF + m * 16;
                const f32x4 c = *(const f32x4*)(cs + (size_t)row * 16 + 4 * fq), s = *(const f32x4*)(sn + (size_t)row * 16 + 4 * fq);
#pragma unroll
                for (int bj = 0; bj < 2; ++bj) { const int cb = u.pn * BM + bj * HALF + wc * 32; const bool rope = ((cb >> 5) % 3) == 2;
                    f32x4 v0 = acc[ai][bj][m][0], v1 = acc[ai][bj][m][1];
                    if (rope) { const f32x4 a = v0 * c - v1 * s, b = v0 * s + v1 * c; v0 = a; v1 = b; }
                    u32x2 w0, w1; w0.x = cvt_pk_bf16(v0[0], v0[1]); w0.y = cvt_pk_bf16(v0[2], v0[3]); w1.x = cvt_pk_bf16(v1[0], v1[1]); w1.y = cvt_pk_bf16(v1[2], v1[3]);
                    bf16_t* p = O + (size_t)row * ldc + cb + 4 * fq; *(u32x2*)p = w0; *(u32x2*)(p + 16) = w1; } }
    }
};

template <class Epi>
__device__ __forceinline__ void gemm_phase(LAS unsigned char* lds, const Gemm g, const StaticOrder& S, const Epi& E, int tid_in) {
    int tid = tid_in; asm volatile("" : "+v"(tid));
    const int wid = __builtin_amdgcn_readfirstlane(tid >> 6), lane = tid & 63, wr = wid >> 2, wc = wid & 3, fr = lane & 15, fq = lane >> 4;
    const int K = g.K, nt = K / BK;
    unsigned voffA[2], voffB[2];
#pragma unroll
    for (int i = 0; i < 2; ++i) { int R, C; stage_rc(tid * 16 + i * 8192, R, C); const int Rb = Epi::PERM ? ((R & ~31) + perm32(R & 31)) : R;
        voffA[i] = (unsigned)(R * g.lda + C) * 2u; voffB[i] = (unsigned)(Rb * g.ldb + C) * 2u; }
    const size_t kstep = (size_t)(BK * 2);
    const size_t hstepA = (size_t)HALF * g.lda * 2, hstepB = (size_t)HALF * g.ldb * 2;
    const size_t tstepA = 2 * hstepA, tstepB = 2 * hstepB;
    const unsigned ldsw = (unsigned)wid * 1024u;
    const int aoff = lds_byte(wr * 64 + fr, fq * 8), boff = lds_byte(wc * 32 + fr, fq * 8);
#define PG8_SA(b, h) (((b) * 2 + (h)) * HTB)
#define PG8_SB(b, h) ((4 + (b) * 2 + (h)) * HTB)
#define PG8_STAGE(bufoff, gbase, voff) do { _Pragma("unroll") for (int _i = 0; _i < 2; ++_i) \
        __builtin_amdgcn_global_load_lds((const unsigned*)((const char*)(gbase) + (voff)[_i]), (LAS unsigned*)(lds + (bufoff) + ldsw + _i * 8192), 16, 0, 0); } while (0)
#define PG8_LDA(dst, b, h) do { _Pragma("unroll") for (int m = 0; m < 4; ++m) _Pragma("unroll") for (int k = 0; k < 2; ++k) dst[m][k] = *(const LAS bf16x8*)(lds + PG8_SA(b, h) + aoff + m * 2048 + k * 1024); } while (0)
#define PG8_LDB(dst, b, h) do { _Pragma("unroll") for (int n = 0; n < 2; ++n) _Pragma("unroll") for (int k = 0; k < 2; ++k) dst[n][k] = *(const LAS bf16x8*)(lds + PG8_SB(b, h) + boff + n * 2048 + k * 1024); } while (0)
#define PG8_MMA(ai, bj, At, Bt) do { __builtin_amdgcn_s_setprio(1); _Pragma("unroll") for (int m = 0; m < 4; ++m) _Pragma("unroll") for (int n = 0; n < 2; ++n) _Pragma("unroll") for (int k = 0; k < 2; ++k) \
        acc[ai][bj][m][n] = __builtin_amdgcn_mfma_f32_16x16x32_bf16(Bt[n][k], At[m][k], acc[ai][bj][m][n], 0, 0, 0); __builtin_amdgcn_s_setprio(0); } while (0)
#define PG8_WAIT_V(n) asm volatile("s_waitcnt vmcnt(" #n ")" ::: "memory")
#define PG8_WAIT_L(n) asm volatile("s_waitcnt lgkmcnt(" #n ")" ::: "memory")
#define PG8_BAR __builtin_amdgcn_s_barrier()
#define PG8_SCHED __builtin_amdgcn_sched_barrier(0)
    Unit cur, nxt; int ui = 0;
    if (!S.next(0, cur)) return;
    f32x4 acc[2][2][4][2];
#pragma unroll
    for (int a = 0; a < 2; ++a)
#pragma unroll
        for (int b = 0; b < 2; ++b)
#pragma unroll
            for (int m = 0; m < 4; ++m)
#pragma unroll
                for (int n = 0; n < 2; ++n) acc[a][b][m][n] = (f32x4){0.f, 0.f, 0.f, 0.f};
    bf16x8 At[4][2], B0[2][2], B1[2][2];
    const char* cA = (const char*)g.A + (size_t)cur.pm * tstepA; const char* cB = (const char*)g.Bt + (size_t)cur.pn * tstepB;
    PG8_STAGE(PG8_SB(0, 0), cB, voffB); PG8_STAGE(PG8_SB(0, 1), cB + hstepB, voffB); PG8_STAGE(PG8_SA(0, 0), cA, voffA); PG8_STAGE(PG8_SA(0, 1), cA + hstepA, voffA);
    if (wr == 1) PG8_BAR;
    PG8_WAIT_V(2); PG8_BAR;
    PG8_STAGE(PG8_SB(1, 0), cB + kstep, voffB); PG8_STAGE(PG8_SA(1, 0), cA + kstep, voffA); PG8_STAGE(PG8_SB(1, 1), cB + hstepB + kstep, voffB);
    PG8_WAIT_V(6); PG8_BAR;
    for (;;) {
        const bool has_next = S.next(ui + 1, nxt);
        const char* nA = has_next ? (const char*)g.A + (size_t)nxt.pm * tstepA : cA; const char* nB = has_next ? (const char*)g.Bt + (size_t)nxt.pn * tstepB : cB;
        for (int t = 0; t < nt; t += 2) {
            const bool last = (t == nt - 2);
            const char* a1 = cA + (size_t)(t + 1) * kstep;
            const char* a2 = last ? nA : cA + (size_t)(t + 2) * kstep; const char* b2 = last ? nB : cB + (size_t)(t + 2) * kstep;
            const char* a3 = a2 + kstep; const char* b3 = b2 + kstep;
            PG8_LDB(B0, 0, 0); PG8_LDB(B1, 0, 1); PG8_SCHED; PG8_LDA(At, 0, 0); PG8_STAGE(PG8_SA(1, 1), a1 + hstepA, voffA);
            PG8_WAIT_V(8); PG8_WAIT_L(0); PG8_BAR; PG8_MMA(0, 0, At, B0); PG8_MMA(0, 1, At, B1); PG8_BAR; PG8_SCHED;
            PG8_LDA(At, 0, 1); PG8_STAGE(PG8_SB(0, 0), b2, voffB); PG8_STAGE(PG8_SB(0, 1), b2 + hstepB, voffB); PG8_STAGE(PG8_SA(0, 0), a2, voffA);
            PG8_WAIT_V(8); PG8_WAIT_L(0); PG8_BAR; PG8_MMA(1, 0, At, B0); PG8_MMA(1, 1, At, B1); PG8_BAR; PG8_SCHED;
            PG8_LDB(B0, 1, 0); PG8_LDB(B1, 1, 1); PG8_SCHED; PG8_LDA(At, 1, 0); PG8_STAGE(PG8_SA(0, 1), a2 + hstepA, voffA);
            PG8_WAIT_V(8); PG8_WAIT_L(0); PG8_BAR; PG8_MMA(0, 0, At, B0); PG8_MMA(0, 1, At, B1); PG8_BAR; PG8_SCHED;
            PG8_LDA(At, 1, 1); PG8_STAGE(PG8_SB(1, 0), b3, voffB); PG8_STAGE(PG8_SB(1, 1), b3 + hstepB, voffB); PG8_STAGE(PG8_SA(1, 0), a3, voffA);
            PG8_WAIT_V(8); PG8_WAIT_L(0); PG8_BAR; PG8_MMA(1, 0, At, B0); PG8_MMA(1, 1, At, B1); PG8_BAR; PG8_SCHED;
        }
        if (wr == 0) PG8_BAR;
        E(acc, cur, wr, wc, fr, fq);
        if (!has_next) break;
#pragma unroll
        for (int a = 0; a < 2; ++a)
#pragma unroll
            for (int b = 0; b < 2; ++b)
#pragma unroll
                for (int m = 0; m < 4; ++m)
#pragma unroll
                    for (int n = 0; n < 2; ++n) acc[a][b][m][n] = (f32x4){0.f, 0.f, 0.f, 0.f};
        cur = nxt; cA = nA; cB = nB; ++ui;
        if (wr == 1) PG8_BAR;
    }
    PG8_WAIT_V(0);
    PG8_BAR;
#undef PG8_SA
#undef PG8_SB
#undef PG8_STAGE
#undef PG8_LDA
#undef PG8_LDB
#undef PG8_MMA
#undef PG8_WAIT_V
#undef PG8_WAIT_L
#undef PG8_BAR
#undef PG8_SCHED
}
}

#define XB_TMO      128
#define XB_XCNT(j)  (256  + 64 * (j))
#define XB_XSUB(j)  (1280 + 64 * (j))
#define XB_XGEN(j)  (2304 + 64 * (j))
#define XB_TOP      3328
#define XB_TOPGEN   3392
#define XCD_BAR_WORDS 3456
#define XB_SPIN_CAP (1u << 18)
__device__ __forceinline__ unsigned xb_ld(unsigned* p)              { return __hip_atomic_load(p, __ATOMIC_RELAXED, __HIP_MEMORY_SCOPE_AGENT); }
__device__ __forceinline__ unsigned xb_add(unsigned* p, unsigned v) { return __hip_atomic_fetch_add(p, v, __ATOMIC_RELAXED, __HIP_MEMORY_SCOPE_AGENT); }
__device__ __forceinline__ unsigned xb_xcc_id() { return (unsigned)__builtin_amdgcn_s_getreg((3 << 11) | 20) & 0xFu; }
#define XB_SPIN(cond, bar) do { unsigned _sp = 0; while (cond) { __builtin_amdgcn_s_sleep(1); \
    if ((++_sp & 255u) == 0u) { if (xb_ld(&(bar)[XB_TMO])) break; if (_sp > XB_SPIN_CAP) { atomicAdd(&(bar)[XB_TMO], 1u); break; } } } } while (0)
struct XcdBarrier { unsigned* bar; unsigned x; volatile LAS unsigned* st; };
__device__ __forceinline__ XcdBarrier xcd_barrier_post(unsigned* bar, volatile LAS unsigned* st) {
    XcdBarrier b; b.bar = bar; b.x = xb_xcc_id(); b.st = st;
    if (threadIdx.x == 0) (void)xb_add(&bar[XB_XCNT(b.x)], 1u);
    return b;
}
__device__ __forceinline__ void xcd_barrier_complete(unsigned* bar, unsigned x, unsigned& nloc, unsigned& nx) {
    const unsigned G = gridDim.x * gridDim.y * gridDim.z;
    unsigned sum, cnt, mine, sp = 0u;
    for (;;) {
        sum = 0u; cnt = 0u; mine = 0u;
#pragma unroll
        for (unsigned j = 0; j < 16; ++j) { const unsigned c = xb_ld(&bar[XB_XCNT(j)]); sum += c; cnt += (c > 0u) ? 1u : 0u; mine = (j == x) ? c : mine; }
        if (sum == G) break;
        __builtin_amdgcn_s_sleep(1);
        if ((++sp & 255u) == 0u) { if (xb_ld(&bar[XB_TMO])) break; if (sp > XB_SPIN_CAP) { atomicAdd(&bar[XB_TMO], 1u); break; } }
    }
    nloc = mine > 0u ? mine : 1u; nx = cnt > 0u ? cnt : 1u;
}
__device__ __forceinline__ void xcd_barrier(const XcdBarrier& b) {
    asm volatile("s_waitcnt vmcnt(0)" ::: "memory");
    __syncthreads();
    if (threadIdx.x == 0) {
        unsigned* bar = b.bar;
        __builtin_amdgcn_s_waitcnt(0);
        unsigned nloc = b.st[0], nx = b.st[1];
        if (nloc == 0u) { xcd_barrier_complete(bar, b.x, nloc, nx); b.st[0] = nloc; b.st[1] = nx; }
        const unsigned old = xb_add(&bar[XB_XSUB(b.x)], 1u);
        const unsigned gen = old / nloc;
        if (old + 1u == (gen + 1u) * nloc) {
            __builtin_amdgcn_fence(__ATOMIC_RELEASE, "agent");
            asm volatile("s_waitcnt vmcnt(0)" ::: "memory");
            const unsigned og = xb_add(&bar[XB_TOP], 1u);
            const unsigned tg = og / nx;
            if (og + 1u == (tg + 1u) * nx) xb_add(&bar[XB_TOPGEN], 1u);
            else XB_SPIN(xb_ld(&bar[XB_TOPGEN]) == tg, bar);
            __builtin_amdgcn_fence(__ATOMIC_ACQUIRE, "agent");
            xb_add(&bar[XB_XGEN(b.x)], 1u);
            asm volatile("s_waitcnt vmcnt(0)" ::: "memory");
        } else {
            XB_SPIN(xb_ld(&bar[XB_XGEN(b.x)]) == gen, bar);
            __builtin_amdgcn_fence(__ATOMIC_ACQUIRE, "agent");
            asm volatile("s_waitcnt vmcnt(0)" ::: "memory");
        }
    }
    __syncthreads();
}

__device__ __forceinline__ float shfl_xor_l(float v, int o, int lane) { return __builtin_bit_cast(float, __builtin_amdgcn_ds_bpermute((lane ^ o) << 2, __builtin_bit_cast(int, v))); }
__device__ __forceinline__ float wave_sum(float v, int lane) {
#pragma unroll
    for (int o = 1; o < 64; o <<= 1) v += shfl_xor_l(v, o, lane);
    return v;
}
__device__ __forceinline__ int lane_id_opaque() { int l; asm volatile("v_mbcnt_lo_u32_b32 %0, -1, 0\n\tv_mbcnt_hi_u32_b32 %0, -1, %0" : "=v"(l)); return l; }
__device__ __forceinline__ void conv_item(const float* W, int ldw, int K, int srccol0, bf16_t* WT, int dstrow0, LAS float* scr, int kb, int lane) {
    const int k0 = 64 * kb;
#pragma unroll 8
    for (int i = 0; i < 32; ++i) { const int kk = 2 * i + (lane >> 5); scr[kk * 33 + (lane & 31)] = W[(size_t)(k0 + kk) * ldw + srccol0 + (lane & 31)]; }
    LDS_WAIT(); asm volatile("" ::: "memory");
    const int c = lane & 7;
#pragma unroll
    for (int j = 0; j < 4; ++j) { const int n = (lane >> 3) + 8 * j; const LAS float* s = scr + (8 * c) * 33 + n;
        u32x4 o; o.x = pk2(s[0 * 33], s[1 * 33]); o.y = pk2(s[2 * 33], s[3 * 33]); o.z = pk2(s[4 * 33], s[5 * 33]); o.w = pk2(s[6 * 33], s[7 * 33]);
        *(u32x4*)(WT + (size_t)(dstrow0 + n) * K + k0 + 8 * c) = o; }
    LDS_WAIT(); asm volatile("" ::: "memory");
}
__device__ __forceinline__ bool conv_job(int& r, const float* W, int ldw, int K, int c0, int type, int ncols, bf16_t* WT, int row0, LAS float* scr, int lane) {
    const int nblk = ncols / 32, nitems = (K / 64) * nblk;
    if (r >= nitems) { r -= nitems; return false; }
    const int kb = r / nblk, n0 = 32 * (r % nblk);
    const int src = type == 0 ? c0 + n0 : c0 + (n0 >> 6) * 128 + (n0 & 63);
    conv_item(W, ldw, K, src, WT, row0 + n0, scr, kb, lane);
    return true;
}
__device__ __forceinline__ void rms_row_bf16(const float* xrow, const float* g, bf16_t* orow, int lane) {
    const f32x4* xr = (const f32x4*)xrow + lane; const f32x4* gr = (const f32x4*)g + lane;
    f32x4 v[4]; float s = 0.f;
#pragma unroll
    for (int j = 0; j < 4; ++j) { v[j] = xr[64 * j]; s += (v[j].x * v[j].x + v[j].y * v[j].y) + (v[j].z * v[j].z + v[j].w * v[j].w); }
    const float rs = 1.0f / sqrtf(wave_sum(s, lane) * (1.0f / 1024.0f) + EPS);
    unsigned long long* o8 = (unsigned long long*)orow + lane;
#pragma unroll
    for (int j = 0; j < 4; ++j) { const f32x4 gv = gr[64 * j]; const f32x4 y = v[j] * rs * gv;
        o8[64 * j] = (unsigned long long)pk2(y.x, y.y) | ((unsigned long long)pk2(y.z, y.w) << 32); }
}
__device__ __forceinline__ void rms_row_f32(const float* xrow, const float* g, float* orow, int lane) {
    const f32x4* xr = (const f32x4*)xrow + lane; const f32x4* gr = (const f32x4*)g + lane;
    f32x4 v[4]; float s = 0.f;
#pragma unroll
    for (int j = 0; j < 4; ++j) { v[j] = xr[64 * j]; s += (v[j].x * v[j].x + v[j].y * v[j].y) + (v[j].z * v[j].z + v[j].w * v[j].w); }
    const float rs = 1.0f / sqrtf(wave_sum(s, lane) * (1.0f / 1024.0f) + EPS);
    f32x4* o = (f32x4*)orow + lane;
#pragma unroll
    for (int j = 0; j < 4; ++j) o[64 * j] = v[j] * rs * gr[64 * j];
}
__device__ __forceinline__ void sincos_acc(float ang, float& sn, float& cs) {
    const double a = (double)ang; const double kd = __builtin_rint(a * 0.6366197723675814); const int k = (int)kd;
    const double r = (a - kd * 1.5707963267948966) - kd * 6.123233995736766e-17, r2 = r * r;
    const double sp = r * (1.0 + r2 * (-1.0 / 6 + r2 * (1.0 / 120 + r2 * (-1.0 / 5040 + r2 * (1.0 / 362880 + r2 * (-1.0 / 39916800))))));
    const double cp = 1.0 + r2 * (-0.5 + r2 * (1.0 / 24 + r2 * (-1.0 / 720 + r2 * (1.0 / 40320 + r2 * (-1.0 / 3628800 + r2 * (1.0 / 479001600))))));
    const int q = k & 3;
    const double s_ = (q == 0) ? sp : (q == 1) ? cp : (q == 2) ? -sp : -cp;
    const double c_ = (q == 0) ? cp : (q == 1) ? -sp : (q == 2) ? -cp : sp;
    sn = (float)s_; cs = (float)c_;
}

template <int DK, int MODE>
__device__ __forceinline__ void attn_wave(const bf16_t* Qp, int ldq, const bf16_t* K1, int ldk1, const bf16_t* K2, int ldk2, const bf16_t* Vt, int ldv,
                                          bf16_t* O, int ldo, int q0, int kt_lo, int kt_hi, float c, float slope, float sinkl, const int* pos, int lane) {
    const int r = lane & 31, hh = lane >> 5;
    bf16x8 qf[DK / 16];
#pragma unroll
    for (int s = 0; s < DK / 16; ++s) qf[s] = *(const bf16x8*)(Qp + (size_t)(q0 + r) * ldq + 16 * s + 8 * hh);
    float m = -1e30f, l = 0.f;
    f32x16 o0, o1;
#pragma unroll
    for (int i = 0; i < 16; ++i) { o0[i] = 0.f; o1[i] = 0.f; }
    const int qi = q0 + r;
    int posq = 0; if (MODE == 1) posq = pos[qi];
    for (int kt = kt_lo; kt < kt_hi; ++kt) {
        const int key0 = kt * 32;
        f32x16 sc;
#pragma unroll
        for (int i = 0; i < 16; ++i) sc[i] = 0.f;
#pragma unroll
        for (int s = 0; s < DK / 16; ++s) {
            bf16x8 kf;
            if (s < 4) kf = *(const bf16x8*)(K1 + (size_t)(key0 + r) * ldk1 + 16 * s + 8 * hh);
            else       kf = *(const bf16x8*)(K2 + (size_t)(key0 + r) * ldk2 + 16 * (s - 4) + 8 * hh);
            sc = __builtin_amdgcn_mfma_f32_32x32x16_bf16(kf, qf[s], sc, 0, 0, 0);
        }
        float tmax = -INFINITY;
#pragma unroll
        for (int i = 0; i < 16; ++i) {
            const int key = key0 + (i & 3) + 8 * (i >> 2) + 4 * hh;
            float v = sc[i] * c;
            if (MODE == 0) { if (key > qi) v = -INFINITY; }
            if (MODE == 1) { const int dist = qi - key; v -= slope * (float)(posq - pos[key]); if (dist < 0 || dist >= 128) v = -INFINITY; }
            sc[i] = v; tmax = fmaxf(tmax, v);
        }
        tmax = fmaxf(tmax, shfl_xor_l(tmax, 32, lane));
        const float mn = fmaxf(m, tmax);
        const float alpha = __builtin_amdgcn_exp2f(m - mn);
        m = mn;
        float ls = 0.f;
#pragma unroll
        for (int i = 0; i < 16; ++i) { const float p = __builtin_amdgcn_exp2f(sc[i] - mn); sc[i] = p; ls += p; }
        l = l * alpha + ls;
#pragma unroll
        for (int i = 0; i < 16; ++i) { o0[i] *= alpha; o1[i] *= alpha; }
        bf16x8 pb[2];
#pragma unroll
        for (int s2 = 0; s2 < 2; ++s2) { u32x4 w; w.x = cvtpk(sc[8 * s2 + 0], sc[8 * s2 + 1]); w.y = cvtpk(sc[8 * s2 + 2], sc[8 * s2 + 3]); w.z = cvtpk(sc[8 * s2 + 4], sc[8 * s2 + 5]); w.w = cvtpk(sc[8 * s2 + 6], sc[8 * s2 + 7]);
            pb[s2] = __builtin_bit_cast(bf16x8, w); }
#pragma unroll
        for (int s2 = 0; s2 < 2; ++s2) {
            const bf16_t* vp0 = Vt + (size_t)r * ldv + key0 + 16 * s2 + 4 * hh;
            const bf16_t* vp1 = vp0 + (size_t)32 * ldv;
            const s16x4 a0 = *(const s16x4*)vp0, a1 = *(const s16x4*)(vp0 + 8);
            const s16x4 b0 = *(const s16x4*)vp1, b1 = *(const s16x4*)(vp1 + 8);
            const bf16x8 vf0 = {a0[0], a0[1], a0[2], a0[3], a1[0], a1[1], a1[2], a1[3]};
            const bf16x8 vf1 = {b0[0], b0[1], b0[2], b0[3], b1[0], b1[1], b1[2], b1[3]};
            o0 = __builtin_amdgcn_mfma_f32_32x32x16_bf16(vf0, pb[s2], o0, 0, 0, 0);
            o1 = __builtin_amdgcn_mfma_f32_32x32x16_bf16(vf1, pb[s2], o1, 0, 0, 0);
        }
    }
    l += shfl_xor_l(l, 32, lane);
    if (MODE == 1) l += __builtin_amdgcn_exp2f(sinkl - m);
    const float inv = 1.0f / l;
    bf16_t* op = O + (size_t)qi * ldo + 4 * hh;
#pragma unroll
    for (int g = 0; g < 4; ++g) {
        u32x2 w0, w1;
        w0.x = cvtpk(o0[4 * g + 0] * inv, o0[4 * g + 1] * inv); w0.y = cvtpk(o0[4 * g + 2] * inv, o0[4 * g + 3] * inv);
        w1.x = cvtpk(o1[4 * g + 0] * inv, o1[4 * g + 1] * inv); w1.y = cvtpk(o1[4 * g + 2] * inv, o1[4 * g + 3] * inv);
        *(u32x2*)(op + 8 * g) = w0; *(u32x2*)(op + 32 + 8 * g) = w1;
    }
}

__device__ __forceinline__ int launder_v(int v) { asm volatile("" : "+v"(v)); return v; }
__device__ __forceinline__ int opaque_zero() { int z; asm volatile("v_mov_b32 %0, 0" : "=v"(z)); return __builtin_amdgcn_readfirstlane(z); }
typedef const char __attribute__((address_space(4)))* kargp_t;
__device__ __forceinline__ unsigned long long opaque_u64(unsigned long long v) {
    const int lo_s = (int)(unsigned)v, hi_s = (int)(unsigned)(v >> 32); int lo, hi;
    asm volatile("v_mov_b32 %0, %2\n\tv_mov_b32 %1, %3" : "=&v"(lo), "=&v"(hi) : "s"(lo_s), "s"(hi_s));
    return ((unsigned long long)(unsigned)__builtin_amdgcn_readfirstlane(hi) << 32) | (unsigned long long)(unsigned)__builtin_amdgcn_readfirstlane(lo);
}
__device__ __forceinline__ const void* ld_arg(kargp_t kp, int byte_off) {
    return *(const void* const __attribute__((address_space(4)))*)(kp + byte_off);
}
#define INP(i) ((const float*)ld_arg(kp, 8 * (i)))
#define COS ((float*)(ws + WS_COS))
#define SIN ((float*)(ws + WS_SIN))
#define MEMN ((bf16_t*)(ws + WS_MEMN))
#define MEMK ((bf16_t*)(ws + WS_MEMK))
#define MEMVT ((bf16_t*)(ws + WS_MEMVT))
#define W_IN ((bf16_t*)(ws + WS_W_IN))
#define W_UQ ((bf16_t*)(ws + WS_W_UQ))
#define W_UK ((bf16_t*)(ws + WS_W_UK))
#define W_UV ((bf16_t*)(ws + WS_W_UV))
#define W_V ((bf16_t*)(ws + WS_W_V))
#define W_MK ((bf16_t*)(ws + WS_W_MK))
#define W_MV ((bf16_t*)(ws + WS_W_MV))
#define W_O ((bf16_t*)(ws + WS_W_O))
#define W_UP ((bf16_t*)(ws + WS_W_UP))
#define W_DN ((bf16_t*)(ws + WS_W_DN))
#define HN ((bf16_t*)(ws + WS_HN))
#define ABUF ((bf16_t*)(ws + WS_ABUF))
#define PROJ ((bf16_t*)(ws + WS_PROJ))
#define QB ((bf16_t*)(ws + WS_Q))
#define KN ((bf16_t*)(ws + WS_KN))
#define VT ((bf16_t*)(ws + WS_VT))
#define ATT ((bf16_t*)(ws + WS_ATT))
#define CQN ((bf16_t*)(ws + WS_CQN))
#define CKVN ((bf16_t*)(ws + WS_CKVN))
#define KROPE ((bf16_t*)(ws + WS_KROPE))
#define x_in INP(0)
#define mem INP(1)
#define positions ((const int*)ld_arg(kp, 16))
#define attn_norm_g INP(3)
#define mlp_norm_g INP(4)
#define mem_norm_g INP(5)
#define final_norm_g INP(6)
#define mla_w_in INP(7)
#define mla_q_norm_g INP(8)
#define mla_kv_norm_g INP(9)
#define mla_w_uq INP(10)
#define mla_w_ukv INP(11)
#define swa_w_in INP(12)
#define swa_sinks INP(13)
#define w_mem_kv INP(14)
#define w_o INP(15)
#define mlp_w_up INP(16)
#define mlp_w_down INP(17)
#define xres ((float*)ld_arg(kp, 144))

struct Args { const void* in[18]; float* out; unsigned char* ws; int ph_lo, ph_hi; };
constexpr int N_PHASES = 33;

__global__ void __launch_bounds__(NWAVES * 64, 2) trunk_fwd(Args args) {
    extern __shared__ __attribute__((aligned(16))) unsigned char lds_raw[];
    LAS unsigned char* lds = (LAS unsigned char*)lds_raw;
    volatile LAS unsigned* MISC = (volatile LAS unsigned*)(lds + MISC_OFF);
    unsigned* ctl = (unsigned*)(args.ws + WS_CTL);
    const int wave0 = __builtin_amdgcn_readfirstlane(threadIdx.x >> 6);
    for (int u = threadIdx.x; u < (LDS_BYTES - LDSCTL_OFF) / 4; u += NWAVES * 64) ((LAS unsigned*)(lds + LDSCTL_OFF))[u] = 0u;
    __syncthreads();
    unsigned bar_x = 0; (void)bar_x;
#if !MK_PER_PHASE_LAUNCH
    { XcdBarrier b0_ = xcd_barrier_post(ctl + CW_BAR, MISC + 8); bar_x = b0_.x; }
#endif
    const int lo = args.ph_lo, hi = args.ph_hi;
    int ph = 0;

#define PHASE_BEGIN if (ph >= lo && ph < hi) { const int zz = opaque_zero(); unsigned char* ws = (unsigned char*)opaque_u64((unsigned long long)args.ws); \
        kargp_t kp = (kargp_t)opaque_u64((unsigned long long)__builtin_amdgcn_kernarg_segment_ptr()); (void)kp; \
        const int tid = wave0 * 64 + lane_id_opaque(); \
        const int G = (int)gridDim.x + zz, bx = (int)blockIdx.x + zz, vcu = (G % 8 == 0) ? (bx % 8) * (G / 8) + bx / 8 : bx, NGW = G * NWAVES; (void)NGW; const int lane = tid & 63, wave = __builtin_amdgcn_readfirstlane(tid >> 6); \
        const int gw = vcu * NWAVES + wave; LAS float* scr = (LAS float*)(lds + wave * 16384); (void)ws; (void)lane; (void)gw; (void)scr;
#if MK_PER_PHASE_LAUNCH
#define PHASE_END } ++ph;
#else
#define PHASE_END if (ph + 1 < hi) { XcdBarrier b_; b_.bar = (unsigned*)ws + CW_BAR; b_.x = bar_x + (unsigned)zz; b_.st = MISC + 8; xcd_barrier(b_); } } ++ph;
#endif
#define CONVERT_LAYER(L) do { const int L_ = (L); const int j_ = L_ >> 1; const bool mla_ = (L_ & 1) == 0; \
        const int total_ = (mla_ ? (16 * 29 + 6 * 36 + 4 * 24 + 4 * 24) : (16 * 32 + 16 * 8 + 16 * 8)) + 16 * 8 + 16 * 8 + 16 * 32 + 16 * 128 + 64 * 32; \
        for (int it_ = gw; it_ < total_; it_ += NGW) { int r_ = it_; \
            if (mla_) { \
                if (conv_job(r_, mla_w_in + (size_t)j_ * 1024 * 928, 928, 1024, 0, 0, 928, W_IN, 0, scr, lane)) continue; \
                if (conv_job(r_, mla_w_uq + (size_t)j_ * 384 * 1152, 1152, 384, 0, 0, 1152, W_UQ, 0, scr, lane)) continue; \
                if (conv_job(r_, mla_w_ukv + (size_t)j_ * 256 * 1536, 1536, 256, 0, 1, 768, W_UK, 0, scr, lane)) continue; \
                if (conv_job(r_, mla_w_ukv + (size_t)j_ * 256 * 1536, 1536, 256, 64, 1, 768, W_UV, 0, scr, lane)) continue; \
            } else { \
                if (conv_job(r_, swa_w_in + (size_t)j_ * 1024 * 1536, 1536, 1024, 0, 0, 1024, W_IN, 0, scr, lane)) continue; \
                if (conv_job(r_, swa_w_in + (size_t)j_ * 1024 * 1536, 1536, 1024, 1280, 0, 256, W_IN, 1024, scr, lane)) continue; \
                if (conv_job(r_, swa_w_in + (size_t)j_ * 1024 * 1536, 1536, 1024, 1024, 0, 256, W_V, 0, scr, lane)) continue; \
            } \
            if (conv_job(r_, w_mem_kv + (size_t)L_ * 1024 * 512, 512, 1024, 0, 0, 256, W_MK, 0, scr, lane)) continue; \
            if (conv_job(r_, w_mem_kv + (size_t)L_ * 1024 * 512, 512, 1024, 256, 0, 256, W_MV, 0, scr, lane)) continue; \
            if (conv_job(r_, w_o + (size_t)L_ * 1024 * 1024, 1024, 1024, 0, 0, 1024, W_O, 0, scr, lane)) continue; \
            if (conv_job(r_, mlp_w_up + (size_t)L_ * 1024 * 4096, 4096, 1024, 0, 0, 4096, W_UP, 0, scr, lane)) continue; \
            (void)conv_job(r_, mlp_w_down + (size_t)L_ * 4096 * 1024, 1024, 4096, 0, 0, 1024, W_DN, 0, scr, lane); \
        } } while (0)

    PHASE_BEGIN
        for (int i = bx * (NWAVES * 64) + tid; i < T * 16; i += G * NWAVES * 64) {
            const int t = i >> 4, f = i & 15; const float ang = (float)positions[t] * rope_inv[f];
            float sn, cs; sincos_acc(ang, sn, cs); COS[i] = cs; SIN[i] = sn;
        }
        for (int rr = gw; rr < NB * NMEM; rr += NGW) rms_row_bf16(mem + (size_t)rr * D, mem_norm_g, MEMN + (size_t)rr * D, lane);
        CONVERT_LAYER(0);
        for (int rr = gw; rr < T; rr += NGW) rms_row_bf16(x_in + (size_t)rr * D, attn_norm_g, HN + (size_t)rr * D, lane);
    PHASE_END

    for (int L = 0; L < DEPTH; ++L) {
        const bool mla = (L & 1) == 0; const int j = L >> 1;
        PHASE_BEGIN
            { pg8::Gemm g{HN, W_IN, T, mla ? 1024 : 1280, 1024, 1024, 1024}; pg8::StaticOrder So; So.init(g.M, g.N, G, bx, 0);
              pg8::EpiBf16<0> E{PROJ, PROJ_LD}; pg8::gemm_phase(lds, g, So, E, tid); }
            if (!mla) {
                int rot = (T / 256) * 5;
                { pg8::Gemm g{W_V, HN, 256, T, 1024, 1024, 1024}; pg8::StaticOrder So; So.init(g.M, g.N, G, bx, rot); rot += 64;
                  pg8::EpiBf16<0> E{VT, T}; pg8::gemm_phase(lds, g, So, E, tid); }
                { pg8::Gemm g{MEMN, W_MK, 1024, 256, 1024, 1024, 1024}; pg8::StaticOrder So; So.init(g.M, g.N, G, bx, rot); rot += 4;
                  pg8::EpiBf16<0> E{MEMK, 256}; pg8::gemm_phase(lds, g, So, E, tid); }
                { pg8::Gemm g{W_MV, MEMN, 256, 1024, 1024, 1024, 1024}; pg8::StaticOrder So; So.init(g.M, g.N, G, bx, rot);
                  pg8::EpiBf16<0> E{MEMVT, 1024}; pg8::gemm_phase(lds, g, So, E, tid); }
            }
        PHASE_END
        if (mla) {
            PHASE_BEGIN
                const float* gq = mla_q_norm_g + j * 384; const float* gkv = mla_kv_norm_g + j * 256;
                for (int t = gw; t < T; t += NGW) {
                    const bf16_t* pr = PROJ + (size_t)t * PROJ_LD;
                    const u32x2 a = *(const u32x2*)(pr + 4 * lane);
                    u32x2 b = {0u, 0u}; if (lane < 32) b = *(const u32x2*)(pr + 256 + 4 * lane);
                    const u32x2 kv = *(const u32x2*)(pr + 384 + 4 * lane);
                    const float a0 = bf2f(a.x & 0xffffu), a1 = bf2f(a.x >> 16), a2 = bf2f(a.y & 0xffffu), a3 = bf2f(a.y >> 16);
                    const float b0 = bf2f(b.x & 0xffffu), b1 = bf2f(b.x >> 16), b2 = bf2f(b.y & 0xffffu), b3 = bf2f(b.y >> 16);
                    const float k0 = bf2f(kv.x & 0xffffu), k1 = bf2f(kv.x >> 16), k2 = bf2f(kv.y & 0xffffu), k3 = bf2f(kv.y >> 16);
                    const float sq = wave_sum((a0 * a0 + a1 * a1) + (a2 * a2 + a3 * a3) + (b0 * b0 + b1 * b1) + (b2 * b2 + b3 * b3), lane);
                    const float skv = wave_sum((k0 * k0 + k1 * k1) + (k2 * k2 + k3 * k3), lane);
                    const float rq = 1.0f / sqrtf(sq * (1.0f / 384.0f) + EPS), rkv = 1.0f / sqrtf(skv * (1.0f / 256.0f) + EPS);
                    { const f32x4 gv = *(const f32x4*)(gq + 4 * lane); u32x2 w; w.x = pk2(a0 * rq * gv.x, a1 * rq * gv.y); w.y = pk2(a2 * rq * gv.z, a3 * rq * gv.w);
                      *(u32x2*)(CQN + (size_t)t * 384 + 4 * lane) = w; }
                    if (lane < 32) { const f32x4 gv = *(const f32x4*)(gq + 256 + 4 * lane); u32x2 w; w.x = pk2(b0 * rq * gv.x, b1 * rq * gv.y); w.y = pk2(b2 * rq * gv.z, b3 * rq * gv.w);
                      *(u32x2*)(CQN + (size_t)t * 384 + 256 + 4 * lane) = w; }
                    { const f32x4 gv = *(const f32x4*)(gkv + 4 * lane); u32x2 w; w.x = pk2(k0 * rkv * gv.x, k1 * rkv * gv.y); w.y = pk2(k2 * rkv * gv.z, k3 * rkv * gv.w);
                      *(u32x2*)(CKVN + (size_t)t * 256 + 4 * lane) = w; }
                    if (lane < 16) { const float x1 = bf2f(pr[640 + lane]), x2 = bf2f(pr[656 + lane]); const float cs = COS[(size_t)t * 16 + lane], sn = SIN[(size_t)t * 16 + lane];
                      KROPE[(size_t)t * 32 + lane] = (bf16_t)f2bf(x1 * cs - x2 * sn); KROPE[(size_t)t * 32 + 16 + lane] = (bf16_t)f2bf(x1 * sn + x2 * cs); }
                }
            PHASE_END
            PHASE_BEGIN
                int rot = 0;
                { pg8::Gemm g{CQN, W_UQ, T, 1280, 384, 384, 384}; pg8::StaticOrder So; So.init(g.M, g.N, G, bx, rot); rot += 64 * 5;
                  pg8::EpiRope E{QB, QLD, COS, SIN}; pg8::gemm_phase(lds, g, So, E, tid); }
                { pg8::Gemm g{CKVN, W_UK, T, 768, 256, 256, 256}; pg8::StaticOrder So; So.init(g.M, g.N, G, bx, rot); rot += 64 * 3;
                  pg8::EpiBf16<0> E{KN, 768}; pg8::gemm_phase(lds, g, So, E, tid); }
                { pg8::Gemm g{W_UV, CKVN, 768, T, 256, 256, 256}; pg8::StaticOrder So; So.init(g.M, g.N, G, bx, rot); rot += 64 * 3;
                  pg8::EpiBf16<0> E{VT, T}; pg8::gemm_phase(lds, g, So, E, tid); }
                { pg8::Gemm g{MEMN, W_MK, 1024, 256, 1024, 1024, 1024}; pg8::StaticOrder So; So.init(g.M, g.N, G, bx, rot); rot += 4;
                  pg8::EpiBf16<0> E{MEMK, 256}; pg8::gemm_phase(lds, g, So, E, tid); }
                { pg8::Gemm g{W_MV, MEMN, 256, 1024, 1024, 1024, 1024}; pg8::StaticOrder So; So.init(g.M, g.N, G, bx, rot);
                  pg8::EpiBf16<0> E{MEMVT, 1024}; pg8::gemm_phase(lds, g, So, E, tid); }
            PHASE_END
        }
        PHASE_BEGIN
            for (int u = bx; u < 1024; u += G) {
                if (u < 768) {
                    const int qb = 15 - u / 48, bh = u % 48, b = bh / 12, h = bh % 12; const int q0 = qb * 256 + wave * 32; const size_t rb = (size_t)b * S;
                    if (mla) {
                        attn_wave<96, 0>(QB + rb * QLD + h * 96, QLD, KN + rb * 768 + h * 64, 768, KROPE + rb * 32, 32, VT + (size_t)(h * 64) * T + rb, T,
                                         ATT + rb * 1024 + h * 64, 1024, q0, 0, q0 / 32 + 1, 0.10206207261596577f * LOG2E, 0.f, 0.f, positions, lane);
                    } else {
                        const int kvh = h / 3; const float slope = __builtin_amdgcn_exp2f(-(float)(h + 1) * (8.0f / 12.0f)) * LOG2E;
                        const float sinkl = swa_sinks[j * 12 + h] * LOG2E; const int kt_lo = (q0 / 32 - 4) > 0 ? (q0 / 32 - 4) : 0;
                        attn_wave<64, 1>(PROJ + rb * PROJ_LD + h * 64, PROJ_LD, PROJ + rb * PROJ_LD + 768 + kvh * 64, PROJ_LD, nullptr, 0, VT + (size_t)(kvh * 64) * T + rb, T,
                                         ATT + rb * 1024 + h * 64, 1024, q0, kt_lo, q0 / 32 + 1, 0.125f * LOG2E, slope, sinkl, positions + rb, lane);
                    }
                } else {
                    const int v = u - 768, qb = v / 16, bh = v % 16, b = bh / 4, hc = bh % 4; const int q0 = qb * 256 + wave * 32; const size_t rb = (size_t)b * S;
                    const int qc_off = mla ? 672 : 1024;
                    attn_wave<64, 2>(PROJ + rb * PROJ_LD + qc_off + hc * 64, PROJ_LD, MEMK + (size_t)(b * NMEM) * 256 + hc * 64, 256, nullptr, 0, MEMVT + (size_t)(hc * 64) * 1024 + b * NMEM, 1024,
                                     ATT + rb * 1024 + 768 + hc * 64, 1024, q0, 0, NMEM / 32, 0.125f * LOG2E, 0.f, 0.f, positions, lane);
                }
            }
        PHASE_END
        PHASE_BEGIN
            { pg8::Gemm g{ATT, W_O, T, 1024, 1024, 1024, 1024}; pg8::StaticOrder So; So.init(g.M, g.N, G, bx, 0);
              pg8::EpiRes E{L == 0 ? x_in : xres, xres, D}; pg8::gemm_phase(lds, g, So, E, tid); }
        PHASE_END
        PHASE_BEGIN
            for (int rr = gw; rr < T; rr += NGW) rms_row_bf16(xres + (size_t)rr * D, mlp_norm_g + L * D, HN + (size_t)rr * D, lane);
        PHASE_END
        PHASE_BEGIN
            { pg8::Gemm g{HN, W_UP, T, FF, 1024, 1024, 1024}; pg8::StaticOrder So; So.init(g.M, g.N, G, bx, 0);
              pg8::EpiBf16<1> E{ABUF, FF}; pg8::gemm_phase(lds, g, So, E, tid); }
        PHASE_END
        PHASE_BEGIN
            { pg8::Gemm g{ABUF, W_DN, T, 1024, FF, FF, FF}; pg8::StaticOrder So; So.init(g.M, g.N, G, bx, 0);
              pg8::EpiRes E{xres, xres, D}; pg8::gemm_phase(lds, g, So, E, tid); }
        PHASE_END
        PHASE_BEGIN
            if (L + 1 < DEPTH) {
                CONVERT_LAYER(L + 1);
                for (int rr = gw; rr < T; rr += NGW) rms_row_bf16(xres + (size_t)rr * D, attn_norm_g + (L + 1) * D, HN + (size_t)rr * D, lane);
            } else {
                for (int rr = gw; rr < T; rr += NGW) rms_row_f32(xres + (size_t)rr * D, final_norm_g, xres + (size_t)rr * D, lane);
            }
        PHASE_END
    }
#undef PHASE_BEGIN
#undef PHASE_END
#undef CONVERT_LAYER
}

extern "C" void kernel_launch(void* const* d_in, const int* in_sizes, int n_in, void* d_out, int out_size, void* d_ws, size_t ws_size, hipStream_t stream) {
    static int grid = 0;
    if (grid == 0) {
        if (n_in != 18 || out_size != T * D || ws_size < WS_END) { fprintf(stderr, "kernel_launch: unexpected shapes (n_in %d out %d ws %zu)\n", n_in, out_size, ws_size); grid = -1; return; }
        int dev = 0, cus = 0, per_cu = 0;
        if (hipGetDevice(&dev) != hipSuccess || hipDeviceGetAttribute(&cus, hipDeviceAttributeMultiprocessorCount, dev) != hipSuccess) { grid = -1; return; }
        if (hipFuncSetAttribute((const void*)trunk_fwd, hipFuncAttributeMaxDynamicSharedMemorySize, LDS_BYTES) != hipSuccess) { fprintf(stderr, "kernel_launch: hipFuncSetAttribute failed\n"); grid = -1; return; }
        if (hipOccupancyMaxActiveBlocksPerMultiprocessor(&per_cu, (const void*)trunk_fwd, NWAVES * 64, LDS_BYTES) != hipSuccess || per_cu < 1)
            fprintf(stderr, "kernel_launch: occupancy query reports %d blocks per CU\n", per_cu);
        (void)hipGetLastError();
        grid = cus;
    }
    if (grid < 0) return;
    (void)hipMemsetAsync((char*)d_ws + WS_CTL, 0, CTL_ZERO_BYTES, stream);
    Args a{};
    for (int i = 0; i < 18; ++i) a.in[i] = d_in[i];
    a.out = (float*)d_out; a.ws = (unsigned char*)d_ws;
#if MK_PER_PHASE_LAUNCH
    for (int p = 0; p < N_PHASES; ++p) { a.ph_lo = p; a.ph_hi = p + 1; hipLaunchKernelGGL(trunk_fwd, dim3(grid), dim3(NWAVES * 64), LDS_BYTES, stream, a); }
#else
    a.ph_lo = 0; a.ph_hi = N_PHASES;
    hipLaunchKernelGGL(trunk_fwd, dim3(grid), dim3(NWAVES * 64), LDS_BYTES, stream, a);
#endif
}
```

```cpp
#include <hip/hip_runtime.h>
#include <cstdio>
#include <cstdint>

#ifndef PROBE_ATT_REPS
#define PROBE_ATT_REPS 1
#endif
#ifndef MK_PER_PHASE_LAUNCH
#define MK_PER_PHASE_LAUNCH 0
#endif

#define LAS __attribute__((address_space(3)))
#define GAS __attribute__((address_space(1)))
typedef unsigned short bf16_t;
typedef short bf16x8 __attribute__((ext_vector_type(8)));
typedef short s16x4 __attribute__((ext_vector_type(4)));
typedef float f32x2 __attribute__((ext_vector_type(2)));
typedef float f32x4 __attribute__((ext_vector_type(4)));
typedef float f32x16 __attribute__((ext_vector_type(16)));
typedef unsigned u32x2 __attribute__((ext_vector_type(2)));
typedef unsigned u32x4 __attribute__((ext_vector_type(4)));
typedef __bf16 bf16x2_t __attribute__((ext_vector_type(2)));

constexpr int NB = 4, S = 4096, T = NB * S, D = 1024, FF = 4096, NMEM = 256, DEPTH = 4;
constexpr int PROJ_LD = 1280;
constexpr int QLD = 1280;
constexpr float EPS = 1e-6f;
constexpr float LOG2E = 1.4426950408889634f;

constexpr size_t MiB = 1u << 20;
constexpr size_t WS_CTL = 0, CTL_ZERO_BYTES = 1 * MiB;
constexpr size_t WS_COS = 1 * MiB, WS_SIN = 2 * MiB;
constexpr size_t WS_MEMN = 3 * MiB;
constexpr size_t WS_MEMK = 5 * MiB, WS_MEMVT = 5 * MiB + 512 * 1024;
constexpr size_t WS_W_IN = 6 * MiB;
constexpr size_t WS_W_UQ = 9 * MiB;
constexpr size_t WS_W_UK = 10 * MiB, WS_W_UV = 10 * MiB + 512 * 1024;
constexpr size_t WS_W_V = 11 * MiB;
constexpr size_t WS_W_MK = 11 * MiB + 512 * 1024, WS_W_MV = 12 * MiB;
constexpr size_t WS_W_O = 13 * MiB;
constexpr size_t WS_W_UP = 15 * MiB;
constexpr size_t WS_W_DN = 23 * MiB;
constexpr size_t WS_HN = 32 * MiB;
constexpr size_t WS_ABUF = 64 * MiB;
constexpr size_t WS_PROJ = 64 * MiB;
constexpr size_t WS_Q = 104 * MiB;
constexpr size_t WS_KN = 144 * MiB;
constexpr size_t WS_VT = 168 * MiB;
constexpr size_t WS_ATT = 192 * MiB;
constexpr size_t WS_CQN = 224 * MiB;
constexpr size_t WS_CKVN = 236 * MiB;
constexpr size_t WS_KROPE = 244 * MiB;
constexpr size_t WS_END = 245 * MiB;
constexpr int CW_ATTQ = 16384;
constexpr int CW_BAR = 4096;

constexpr int RING_BYTES = 131072;
constexpr int LDSCTL_OFF = RING_BYTES, MISC_OFF = LDSCTL_OFF + 320;
constexpr int LDS_BYTES = 147456;
constexpr int NWAVES = 8;

__device__ const float rope_inv[16] = {1.0f, 0.5623413251903491f, 0.31622776601683794f, 0.1778279410038923f, 0.1f, 0.05623413251903491f,
    0.03162277660168379f, 0.01778279410038923f, 0.01f, 0.005623413251903491f, 0.0031622776601683794f, 0.0017782794100389228f, 0.001f,
    0.0005623413251903491f, 0.00031622776601683794f, 0.00017782794100389227f};

__device__ __forceinline__ unsigned f2bf(float f) { unsigned u = __builtin_bit_cast(unsigned, f); return (u + 0x7fffu + ((u >> 16) & 1u)) >> 16; }
__device__ __forceinline__ unsigned pk2(float lo, float hi) { return f2bf(lo) | (f2bf(hi) << 16); }
__device__ __forceinline__ float bf2f(unsigned b) { return __builtin_bit_cast(float, b << 16); }
__device__ __forceinline__ unsigned cvtpk(float lo, float hi) { f32x2 v = {lo, hi}; bf16x2_t b = __builtin_convertvector(v, bf16x2_t); return __builtin_bit_cast(unsigned, b); }
#define LDS_WAIT() asm volatile("s_waitcnt lgkmcnt(0)" ::: "memory")
#define VM_WAIT() asm volatile("s_waitcnt vmcnt(0)" ::: "memory")

namespace pg8 {
constexpr int BM = 256, BK = 64, HALF = 128, HTB = HALF * BK * 2, STAGE_BYTES = 8 * HTB, NXCD = 8, WGM = 8;
__host__ __device__ __forceinline__ int lds_byte(int r, int c) { const int st = (r >> 4) * 2 + (c >> 5), rr = r & 15, cc = c & 31, ob = rr * 64 + cc * 2; return st * 1024 + (ob ^ (((ob >> 9) & 1) << 5)); }
__host__ __device__ __forceinline__ void stage_rc(int b, int& R, int& C) { const int st = b / 1024, sb = b % 1024, swz = sb ^ (((sb >> 9) & 1) << 5); R = (st >> 1) * 16 + swz / 64; C = (st & 1) * 32 + (swz % 64) / 2; }
__host__ __device__ __forceinline__ int perm32(int rho) { const int n = rho >> 4, i = rho & 15; return 8 * (i >> 2) + 4 * n + (i & 3); }

struct Unit { int pm, pn; };
struct Gemm { const bf16_t* A; const bf16_t* Bt; int M, N, K, lda, ldb; };

struct StaticOrder {
    int nM, nN, nwg, G, c;
    __device__ void init(int M, int N, int G_, int c_, int rot) { nM = M / BM; nN = N / BM; nwg = nM * nN; G = G_; c = (c_ + G_ - (rot % G_)) % G_; }
    __device__ bool next(int i, Unit& u) const {
        const long L = (long)i * G + c; if (L >= nwg) return false;
        int wgid = (int)L; { const int q = nwg / NXCD, r = nwg % NXCD, xcd = wgid % NXCD, off = wgid / NXCD; wgid = (xcd < r ? xcd * (q + 1) : r * (q + 1) + (xcd - r) * q) + off; }
        const int nig = WGM * nN, gid = wgid / nig, fm = gid * WGM, gsz = (nM - fm) < WGM ? (nM - fm) : WGM;
        u.pm = fm + ((wgid % nig) % gsz); u.pn = (wgid % nig) / gsz; return true;
    }
};

__device__ __forceinline__ unsigned cvt_pk_bf16(float lo, float hi) { unsigned r; asm volatile("v_cvt_pk_bf16_f32 %0, %1, %2" : "=v"(r) : "v"(lo), "v"(hi)); return r; }

template <int ACT  > struct EpiBf16 {
    static constexpr bool PERM = true;
    bf16_t* O; int ldc;
    __device__ __forceinline__ void operator()(const f32x4 (&acc)[2][2][4][2], const Unit& u, int wr, int wc, int fr, int fq) const {
        const int row0 = u.pm * BM + wr * 64 + fr; const int col0 = u.pn * BM + wc * 32 + 8 * fq;
#pragma unroll
        for (int ai = 0; ai < 2; ++ai)
#pragma unroll
            for (int m = 0; m < 4; ++m) { bf16_t* rowp = O + (size_t)(row0 + ai * HALF + m * 16) * ldc + col0;
#pragma unroll
                for (int bj = 0; bj < 2; ++bj) { f32x4 v0 = acc[ai][bj][m][0], v1 = acc[ai][bj][m][1];
                    if (ACT == 1) {
#pragma unroll
                        for (int e = 0; e < 4; ++e) { const float a = fmaxf(v0[e], 0.f), b = fmaxf(v1[e], 0.f); v0[e] = a * a; v1[e] = b * b; } }
                    u32x4 w; w.x = cvt_pk_bf16(v0[0], v0[1]); w.y = cvt_pk_bf16(v0[2], v0[3]); w.z = cvt_pk_bf16(v1[0], v1[1]); w.w = cvt_pk_bf16(v1[2], v1[3]);
                    *(u32x4*)(rowp + bj * HALF) = w; } }
    }
};
struct EpiRes {
    static constexpr bool PERM = false;
    const float* base; float* out; int ldc;
    __device__ __forceinline__ void operator()(const f32x4 (&acc)[2][2][4][2], const Unit& u, int wr, int wc, int fr, int fq) const {
        const int row0 = u.pm * BM + wr * 64 + fr, col0 = u.pn * BM + wc * 32 + 4 * fq;
#pragma unroll
        for (int ai = 0; ai < 2; ++ai)
#pragma unroll
            for (int m = 0; m < 4; ++m) { const size_t off = (size_t)(row0 + ai * HALF + m * 16) * ldc + col0;
#pragma unroll
                for (int bj = 0; bj < 2; ++bj)
#pragma unroll
                    for (int n = 0; n < 2; ++n) { const f32x4 b = *(const f32x4*)(base + off + bj * HALF + n * 16); *(f32x4*)(out + off + bj * HALF + n * 16) = b + acc[ai][bj][m][n]; } }
    }
};
struct EpiRope {
    static constexpr bool PERM = false;
    bf16_t* O; int ldc; const float* cs; const float* sn;
    __device__ __forceinline__ void operator()(const f32x4 (&acc)[2][2][4][2], const Unit& u, int wr, int wc, int fr, int fq) const {
        const int row0 = u.pm * BM + wr * 64 + fr;
#pragma unroll
        for (int ai = 0; ai < 2; ++ai)
#pragma unroll
            for (int m = 0; m < 4; ++m) { const int row = row0 + ai * HALF + m * 16;
                const f32x4 c = *(const f32x4*)(cs + (size_t)row * 16 + 4 * fq), s = *(const f32x4*)(sn + (size_t)row * 16 + 4 * fq);
#pragma unroll
                for (int bj = 0; bj < 2; ++bj) { const int cb = u.pn * BM + bj * HALF + wc * 32; const bool rope = ((cb >> 5) % 3) == 2;
                    f32x4 v0 = acc[ai][bj][m][0], v1 = acc[ai][bj][m][1];
                    if (rope) { const f32x4 a = v0 * c - v1 * s, b = v0 * s + v1 * c; v0 = a; v1 = b; }
                    u32x2 w0, w1; w0.x = cvt_pk_bf16(v0[0], v0[1]); w0.y = cvt_pk_bf16(v0[2], v0[3]); w1.x = cvt_pk_bf16(v1[0], v1[1]); w1.y = cvt_pk_bf16(v1[2], v1[3]);
                    bf16_t* p = O + (size_t)row * ldc + cb + 4 * fq; *(u32x2*)p = w0; *(u32x2*)(p + 16) = w1; } }
    }
};

template <class Epi>
__device__ __forceinline__ void gemm_phase(LAS unsigned char* lds, const Gemm g, const StaticOrder& S, const Epi& E, int wave_sgpr) {
    int tid; asm volatile("v_mbcnt_lo_u32_b32 %0, -1, 0\n\tv_mbcnt_hi_u32_b32 %0, -1, %0" : "=v"(tid)); tid += wave_sgpr * 64;
    const int wid = __builtin_amdgcn_readfirstlane(tid >> 6), lane = tid & 63, wr = wid >> 2, wc = wid & 3, fr = lane & 15, fq = lane >> 4;
    const int K = g.K, nt = K / BK;
    unsigned voffA[2], voffB[2];
#pragma unroll
    for (int i = 0; i < 2; ++i) { int R, C; stage_rc(tid * 16 + i * 8192, R, C); const int Rb = Epi::PERM ? ((R & ~31) + perm32(R & 31)) : R;
        voffA[i] = (unsigned)(R * g.lda + C) * 2u; voffB[i] = (unsigned)(Rb * g.ldb + C) * 2u; }
    const size_t kstep = (size_t)(BK * 2);
    const size_t hstepA = (size_t)HALF * g.lda * 2, hstepB = (size_t)HALF * g.ldb * 2;
    const size_t tstepA = 2 * hstepA, tstepB = 2 * hstepB;
    const unsigned ldsw = (unsigned)wid * 1024u;
    const int aoff = lds_byte(wr * 64 + fr, fq * 8), boff = lds_byte(wc * 32 + fr, fq * 8);
#define PG8_SA(b, h) (((b) * 2 + (h)) * HTB)
#define PG8_SB(b, h) ((4 + (b) * 2 + (h)) * HTB)
#define PG8_STAGE(bufoff, gbase, voff) do { _Pragma("unroll") for (int _i = 0; _i < 2; ++_i) \
        __builtin_amdgcn_global_load_lds((const unsigned*)((const char*)(gbase) + (voff)[_i]), (LAS unsigned*)(lds + (bufoff) + ldsw + _i * 8192), 16, 0, 0); } while (0)
#define PG8_LDA(dst, b, h) do { _Pragma("unroll") for (int m = 0; m < 4; ++m) _Pragma("unroll") for (int k = 0; k < 2; ++k) dst[m][k] = *(const LAS bf16x8*)(lds + PG8_SA(b, h) + aoff + m * 2048 + k * 1024); } while (0)
#define PG8_LDB(dst, b, h) do { _Pragma("unroll") for (int n = 0; n < 2; ++n) _Pragma("unroll") for (int k = 0; k < 2; ++k) dst[n][k] = *(const LAS bf16x8*)(lds + PG8_SB(b, h) + boff + n * 2048 + k * 1024); } while (0)
#define PG8_MMA(ai, bj, At, Bt) do { __builtin_amdgcn_s_setprio(1); _Pragma("unroll") for (int m = 0; m < 4; ++m) _Pragma("unroll") for (int n = 0; n < 2; ++n) _Pragma("unroll") for (int k = 0; k < 2; ++k) \
        acc[ai][bj][m][n] = __builtin_amdgcn_mfma_f32_16x16x32_bf16(Bt[n][k], At[m][k], acc[ai][bj][m][n], 0, 0, 0); __builtin_amdgcn_s_setprio(0); } while (0)
#define PG8_WAIT_V(n) asm volatile("s_waitcnt vmcnt(" #n ")" ::: "memory")
#define PG8_WAIT_L(n) asm volatile("s_waitcnt lgkmcnt(" #n ")" ::: "memory")
#define PG8_BAR __builtin_amdgcn_s_barrier()
#define PG8_SCHED __builtin_amdgcn_sched_barrier(0)
    Unit cur, nxt; int ui = 0;
    if (!S.next(0, cur)) return;
    f32x4 acc[2][2][4][2];
#pragma unroll
    for (int a = 0; a < 2; ++a)
#pragma unroll
        for (int b = 0; b < 2; ++b)
#pragma unroll
            for (int m = 0; m < 4; ++m)
#pragma unroll
                for (int n = 0; n < 2; ++n) acc[a][b][m][n] = (f32x4){0.f, 0.f, 0.f, 0.f};
    bf16x8 At[4][2], B0[2][2], B1[2][2];
    const char* cA = (const char*)g.A + (size_t)cur.pm * tstepA; const char* cB = (const char*)g.Bt + (size_t)cur.pn * tstepB;
    PG8_STAGE(PG8_SB(0, 0), cB, voffB); PG8_STAGE(PG8_SB(0, 1), cB + hstepB, voffB); PG8_STAGE(PG8_SA(0, 0), cA, voffA); PG8_STAGE(PG8_SA(0, 1), cA + hstepA, voffA);
    if (wr == 1) PG8_BAR;
    PG8_WAIT_V(2); PG8_BAR;
    PG8_STAGE(PG8_SB(1, 0), cB + kstep, voffB); PG8_STAGE(PG8_SA(1, 0), cA + kstep, voffA); PG8_STAGE(PG8_SB(1, 1), cB + hstepB + kstep, voffB);
    PG8_WAIT_V(6); PG8_BAR;
    for (;;) {
        const bool has_next = S.next(ui + 1, nxt);
        const char* nA = has_next ? (const char*)g.A + (size_t)nxt.pm * tstepA : cA; const char* nB = has_next ? (const char*)g.Bt + (size_t)nxt.pn * tstepB : cB;
        for (int t = 0; t < nt; t += 2) {
            const bool last = (t == nt - 2);
            const char* a1 = cA + (size_t)(t + 1) * kstep;
            const char* a2 = last ? nA : cA + (size_t)(t + 2) * kstep; const char* b2 = last ? nB : cB + (size_t)(t + 2) * kstep;
            const char* a3 = a2 + kstep; const char* b3 = b2 + kstep;
            PG8_LDB(B0, 0, 0); PG8_LDB(B1, 0, 1); PG8_SCHED; PG8_LDA(At, 0, 0); PG8_STAGE(PG8_SA(1, 1), a1 + hstepA, voffA);
            PG8_WAIT_V(8); PG8_WAIT_L(0); PG8_BAR; PG8_MMA(0, 0, At, B0); PG8_MMA(0, 1, At, B1); PG8_BAR; PG8_SCHED;
            PG8_LDA(At, 0, 1); PG8_STAGE(PG8_SB(0, 0), b2, voffB); PG8_STAGE(PG8_SB(0, 1), b2 + hstepB, voffB); PG8_STAGE(PG8_SA(0, 0), a2, voffA);
            PG8_WAIT_V(8); PG8_WAIT_L(0); PG8_BAR; PG8_MMA(1, 0, At, B0); PG8_MMA(1, 1, At, B1); PG8_BAR; PG8_SCHED;
            PG8_LDB(B0, 1, 0); PG8_LDB(B1, 1, 1); PG8_SCHED; PG8_LDA(At, 1, 0); PG8_STAGE(PG8_SA(0, 1), a2 + hstepA, voffA);
            PG8_WAIT_V(8); PG8_WAIT_L(0); PG8_BAR; PG8_MMA(0, 0, At, B0); PG8_MMA(0, 1, At, B1); PG8_BAR; PG8_SCHED;
            PG8_LDA(At, 1, 1); PG8_STAGE(PG8_SB(1, 0), b3, voffB); PG8_STAGE(PG8_SB(1, 1), b3 + hstepB, voffB); PG8_STAGE(PG8_SA(1, 0), a3, voffA);
            PG8_WAIT_V(8); PG8_WAIT_L(0); PG8_BAR; PG8_MMA(1, 0, At, B0); PG8_MMA(1, 1, At, B1); PG8_BAR; PG8_SCHED;
        }
        if (wr == 0) PG8_BAR;
        E(acc, cur, wr, wc, fr, fq);
        if (!has_next) break;
#pragma unroll
        for (int a = 0; a < 2; ++a)
#pragma unroll
            for (int b = 0; b < 2; ++b)
#pragma unroll
                for (int m = 0; m < 4; ++m)
#pragma unroll
                    for (int n = 0; n < 2; ++n) acc[a][b][m][n] = (f32x4){0.f, 0.f, 0.f, 0.f};
        cur = nxt; cA = nA; cB = nB; ++ui;
        if (wr == 1) PG8_BAR;
    }
    PG8_WAIT_V(0);
    PG8_BAR;
#undef PG8_SA
#undef PG8_SB
#undef PG8_STAGE
#undef PG8_LDA
#undef PG8_LDB
#undef PG8_MMA
#undef PG8_WAIT_V
#undef PG8_WAIT_L
#undef PG8_BAR
#undef PG8_SCHED
}
}

#define XB_TMO      128
#define XB_XCNT(j)  (256  + 64 * (j))
#define XB_XSUB(j)  (1280 + 64 * (j))
#define XB_XGEN(j)  (2304 + 64 * (j))
#define XB_TOP      3328
#define XB_TOPGEN   3392
#define XCD_BAR_WORDS 3456
#define XB_SPIN_CAP (1u << 18)
__device__ __forceinline__ unsigned xb_ld(unsigned* p)              { return __hip_atomic_load(p, __ATOMIC_RELAXED, __HIP_MEMORY_SCOPE_AGENT); }
__device__ __forceinline__ unsigned xb_add(unsigned* p, unsigned v) { return __hip_atomic_fetch_add(p, v, __ATOMIC_RELAXED, __HIP_MEMORY_SCOPE_AGENT); }
__device__ __forceinline__ unsigned xb_xcc_id() { return (unsigned)__builtin_amdgcn_s_getreg((3 << 11) | 20) & 0xFu; }
#define XB_SPIN(cond, bar) do { unsigned _sp = 0; while (cond) { __builtin_amdgcn_s_sleep(1); \
    if ((++_sp & 255u) == 0u) { if (xb_ld(&(bar)[XB_TMO])) break; if (_sp > XB_SPIN_CAP) { atomicAdd(&(bar)[XB_TMO], 1u); break; } } } } while (0)
struct XcdBarrier { unsigned* bar; unsigned x; volatile LAS unsigned* st; };
__device__ __forceinline__ XcdBarrier xcd_barrier_post(unsigned* bar, volatile LAS unsigned* st) {
    XcdBarrier b; b.bar = bar; b.x = xb_xcc_id(); b.st = st;
    if (threadIdx.x == 0) (void)xb_add(&bar[XB_XCNT(b.x)], 1u);
    return b;
}
__device__ __forceinline__ void xcd_barrier_complete(unsigned* bar, unsigned x, unsigned& nloc, unsigned& nx) {
    const unsigned G = gridDim.x * gridDim.y * gridDim.z;
    unsigned sum, cnt, mine, sp = 0u;
    for (;;) {
        sum = 0u; cnt = 0u; mine = 0u;
#pragma unroll
        for (unsigned j = 0; j < 16; ++j) { const unsigned c = xb_ld(&bar[XB_XCNT(j)]); sum += c; cnt += (c > 0u) ? 1u : 0u; mine = (j == x) ? c : mine; }
        if (sum == G) break;
        __builtin_amdgcn_s_sleep(1);
        if ((++sp & 255u) == 0u) { if (xb_ld(&bar[XB_TMO])) break; if (sp > XB_SPIN_CAP) { atomicAdd(&bar[XB_TMO], 1u); break; } }
    }
    nloc = mine > 0u ? mine : 1u; nx = cnt > 0u ? cnt : 1u;
}
__device__ __forceinline__ void xcd_barrier(const XcdBarrier& b) {
    asm volatile("s_waitcnt vmcnt(0)" ::: "memory");
    __syncthreads();
    if (threadIdx.x == 0) {
        unsigned* bar = b.bar;
        __builtin_amdgcn_s_waitcnt(0);
        unsigned nloc = b.st[0], nx = b.st[1];
        if (nloc == 0u) { xcd_barrier_complete(bar, b.x, nloc, nx); b.st[0] = nloc; b.st[1] = nx; }
        const unsigned old = xb_add(&bar[XB_XSUB(b.x)], 1u);
        const unsigned gen = old / nloc;
        if (old + 1u == (gen + 1u) * nloc) {
            __builtin_amdgcn_fence(__ATOMIC_RELEASE, "agent");
            asm volatile("s_waitcnt vmcnt(0)" ::: "memory");
            const unsigned og = xb_add(&bar[XB_TOP], 1u);
            const unsigned tg = og / nx;
            if (og + 1u == (tg + 1u) * nx) xb_add(&bar[XB_TOPGEN], 1u);
            else XB_SPIN(xb_ld(&bar[XB_TOPGEN]) == tg, bar);
            __builtin_amdgcn_fence(__ATOMIC_ACQUIRE, "agent");
            xb_add(&bar[XB_XGEN(b.x)], 1u);
            asm volatile("s_waitcnt vmcnt(0)" ::: "memory");
        } else {
            XB_SPIN(xb_ld(&bar[XB_XGEN(b.x)]) == gen, bar);
            __builtin_amdgcn_fence(__ATOMIC_ACQUIRE, "agent");
            asm volatile("s_waitcnt vmcnt(0)" ::: "memory");
        }
    }
    __syncthreads();
}

__device__ __forceinline__ float shfl_xor_l(float v, int o, int lane) { return __builtin_bit_cast(float, __builtin_amdgcn_ds_bpermute((lane ^ o) << 2, __builtin_bit_cast(int, v))); }
__device__ __forceinline__ float wave_sum(float v, int lane) {
#pragma unroll
    for (int o = 1; o < 64; o <<= 1) v += shfl_xor_l(v, o, lane);
    return v;
}
__device__ __forceinline__ int lane_id_opaque() { int l; asm volatile("v_mbcnt_lo_u32_b32 %0, -1, 0\n\tv_mbcnt_hi_u32_b32 %0, -1, %0" : "=v"(l)); return l; }
__device__ __forceinline__ void conv_item(const float* W, int ldw, int K, int srccol0, bf16_t* WT, int dstrow0, LAS float* scr, int kb, int lane) {
    const int k0 = 64 * kb;
#pragma unroll 8
    for (int i = 0; i < 32; ++i) { const int kk = 2 * i + (lane >> 5); scr[kk * 33 + (lane & 31)] = W[(size_t)(k0 + kk) * ldw + srccol0 + (lane & 31)]; }
    LDS_WAIT(); asm volatile("" ::: "memory");
    const int c = lane & 7;
#pragma unroll
    for (int j = 0; j < 4; ++j) { const int n = (lane >> 3) + 8 * j; const LAS float* s = scr + (8 * c) * 33 + n;
        u32x4 o; o.x = pk2(s[0 * 33], s[1 * 33]); o.y = pk2(s[2 * 33], s[3 * 33]); o.z = pk2(s[4 * 33], s[5 * 33]); o.w = pk2(s[6 * 33], s[7 * 33]);
        *(u32x4*)(WT + (size_t)(dstrow0 + n) * K + k0 + 8 * c) = o; }
    LDS_WAIT(); asm volatile("" ::: "memory");
}
__device__ __forceinline__ bool conv_job(int& r, const float* W, int ldw, int K, int c0, int type, int ncols, bf16_t* WT, int row0, LAS float* scr, int lane) {
    const int nblk = ncols / 32, nitems = (K / 64) * nblk;
    if (r >= nitems) { r -= nitems; return false; }
    const int kb = r / nblk, n0 = 32 * (r % nblk);
    const int src = type == 0 ? c0 + n0 : c0 + (n0 >> 6) * 128 + (n0 & 63);
    conv_item(W, ldw, K, src, WT, row0 + n0, scr, kb, lane);
    return true;
}
__device__ __forceinline__ void rms_row_bf16(const float* xrow, const float* g, bf16_t* orow, int lane) {
    const f32x4* xr = (const f32x4*)xrow + lane; const f32x4* gr = (const f32x4*)g + lane;
    f32x4 v[4]; float s = 0.f;
#pragma unroll
    for (int j = 0; j < 4; ++j) { v[j] = xr[64 * j]; s += (v[j].x * v[j].x + v[j].y * v[j].y) + (v[j].z * v[j].z + v[j].w * v[j].w); }
    const float rs = 1.0f / sqrtf(wave_sum(s, lane) * (1.0f / 1024.0f) + EPS);
    unsigned long long* o8 = (unsigned long long*)orow + lane;
#pragma unroll
    for (int j = 0; j < 4; ++j) { const f32x4 gv = gr[64 * j]; const f32x4 y = v[j] * rs * gv;
        o8[64 * j] = (unsigned long long)pk2(y.x, y.y) | ((unsigned long long)pk2(y.z, y.w) << 32); }
}
__device__ __forceinline__ void rms_row_f32(const float* xrow, const float* g, float* orow, int lane) {
    const f32x4* xr = (const f32x4*)xrow + lane; const f32x4* gr = (const f32x4*)g + lane;
    f32x4 v[4]; float s = 0.f;
#pragma unroll
    for (int j = 0; j < 4; ++j) { v[j] = xr[64 * j]; s += (v[j].x * v[j].x + v[j].y * v[j].y) + (v[j].z * v[j].z + v[j].w * v[j].w); }
    const float rs = 1.0f / sqrtf(wave_sum(s, lane) * (1.0f / 1024.0f) + EPS);
    f32x4* o = (f32x4*)orow + lane;
#pragma unroll
    for (int j = 0; j < 4; ++j) o[64 * j] = v[j] * rs * gr[64 * j];
}
__device__ __forceinline__ void sincos_acc(float ang, float& sn, float& cs) {
    const double a = (double)ang; const double kd = __builtin_rint(a * 0.6366197723675814); const int k = (int)kd;
    const double r = (a - kd * 1.5707963267948966) - kd * 6.123233995736766e-17, r2 = r * r;
    const double sp = r * (1.0 + r2 * (-1.0 / 6 + r2 * (1.0 / 120 + r2 * (-1.0 / 5040 + r2 * (1.0 / 362880 + r2 * (-1.0 / 39916800))))));
    const double cp = 1.0 + r2 * (-0.5 + r2 * (1.0 / 24 + r2 * (-1.0 / 720 + r2 * (1.0 / 40320 + r2 * (-1.0 / 3628800 + r2 * (1.0 / 479001600))))));
    const int q = k & 3;
    const double s_ = (q == 0) ? sp : (q == 1) ? cp : (q == 2) ? -sp : -cp;
    const double c_ = (q == 0) ? cp : (q == 1) ? -sp : (q == 2) ? -cp : sp;
    sn = (float)s_; cs = (float)c_;
}

namespace att {
constexpr int KROW = 208, VROW = 144, KT_BYTES = 64 * KROW, VT_BYTES = 64 * VROW, POS_OFF = KT_BYTES + VT_BYTES, BUF_BYTES = POS_OFF + 256, SLOT_OFF = 2 * BUF_BYTES;
template <int DK, int MODE>
__device__ __forceinline__ void attn_unit(LAS unsigned char* lds, const GAS bf16_t* Qp, int ldq, const GAS bf16_t* K1, int ldk1, const GAS bf16_t* K2, const GAS bf16_t* Vt, int ldv,
                                          GAS bf16_t* O, int ldo, int q0, int t_lo, int t_hi, float c, float slope, float sinkl, const GAS int* pos, int tid) {
    const int wave = __builtin_amdgcn_readfirstlane(tid >> 6), lane = tid & 63, r = lane & 31, hh = lane >> 5;
    const int qw = q0 + 32 * wave, qi = qw + r;
    bf16x8 qf[DK / 16];
#pragma unroll
    for (int s = 0; s < DK / 16; ++s) qf[s] = *(const GAS bf16x8*)(Qp + (size_t)qi * ldq + 16 * s + 8 * hh);
    float m = -1e30f, l = 0.f;
    f32x16 o0, o1;
#pragma unroll
    for (int i = 0; i < 16; ++i) { o0[i] = 0.f; o1[i] = 0.f; }
    int posq = 0; if (MODE == 1) posq = pos[qi];
    const int sk_row = tid >> 3, sk_ch = tid & 7;
    const GAS bf16_t* gk1 = K1 + (size_t)(t_lo * 64 + sk_row) * ldk1 + sk_ch * 8;
    const GAS bf16_t* gk2 = K2 + (size_t)(t_lo * 64 + (tid >> 2)) * 32 + (tid & 3) * 8;
    const GAS bf16_t* gv = Vt + (size_t)sk_row * ldv + t_lo * 64 + sk_ch * 8;
    const int kw_off = sk_row * KROW + sk_ch * 16, k2w_off = (tid >> 2) * KROW + 128 + (tid & 3) * 16, vw_off = KT_BYTES + sk_row * VROW + (sk_ch >> 1) * 32 + (sk_ch & 1) * 8;
    const bool has_k2 = (DK == 96) && (tid < 256), has_pos = (MODE == 1) && (tid < 64);
    u32x4 rk1, rk2 = {0u, 0u, 0u, 0u}, rv; int rp = 0;
#define ATT_LOAD(tile) do { rk1 = *(const GAS u32x4*)gk1; if (has_k2) rk2 = *(const GAS u32x4*)gk2; rv = *(const GAS u32x4*)gv; if (has_pos) rp = pos[(tile) * 64 + tid]; } while (0)
#define ATT_STORE(buf) do { LAS unsigned char* b_ = lds + (buf) * BUF_BYTES; *(LAS u32x4*)(b_ + kw_off) = rk1; if (has_k2) *(LAS u32x4*)(b_ + k2w_off) = rk2; \
        *(LAS u32x2*)(b_ + vw_off) = (u32x2){rv.x, rv.y}; *(LAS u32x2*)(b_ + vw_off + 16) = (u32x2){rv.z, rv.w}; if (has_pos) *(LAS int*)(b_ + POS_OFF + 4 * tid) = rp; } while (0)
    ATT_LOAD(t_lo);
    ATT_STORE(0);
    __syncthreads();
    const int frag_off = r * KROW + hh * 16, vfrag_off = KT_BYTES + r * VROW + hh * 16;
    for (int t = t_lo; t < t_hi; ++t) {
        const int cur = (t - t_lo) & 1;
        const bool has_next = (t + 1 < t_hi);
        if (has_next) { gk1 += (size_t)64 * ldk1; gk2 += 64 * 32; gv += 64; ATT_LOAD(t + 1); }
        const int key0 = t * 64;
        bool need = true;
        if (MODE == 0) need = key0 <= qw + 31;
        if (MODE == 1) need = (key0 <= qw + 31) && (key0 + 63 >= qw - 127);
        if (need) {
            const LAS unsigned char* kb = lds + cur * BUF_BYTES;
            f32x16 s0, s1;
#pragma unroll
            for (int i = 0; i < 16; ++i) { s0[i] = 0.f; s1[i] = 0.f; }
#pragma unroll
            for (int s = 0; s < DK / 16; ++s) {
                const bf16x8 k0f = *(const LAS bf16x8*)(kb + frag_off + s * 32);
                const bf16x8 k1f = *(const LAS bf16x8*)(kb + frag_off + 32 * KROW + s * 32);
                s0 = __builtin_amdgcn_mfma_f32_32x32x16_bf16(k0f, qf[s], s0, 0, 0, 0);
                s1 = __builtin_amdgcn_mfma_f32_32x32x16_bf16(k1f, qf[s], s1, 0, 0, 0);
            }
            float smax = -INFINITY, mn;
            if (MODE == 1) {
                const LAS int* pk = (const LAS int*)(kb + POS_OFF);
#pragma unroll
                for (int i = 0; i < 16; ++i) {
                    const int kk = (i & 3) + 8 * (i >> 2) + 4 * hh; const int d0 = qi - (key0 + kk), d1 = d0 - 32;
                    float v0 = fmaf(s0[i], c, -slope * (float)(posq - pk[kk])), v1 = fmaf(s1[i], c, -slope * (float)(posq - pk[kk + 32]));
                    if (d0 < 0 || d0 >= 128) v0 = -INFINITY;
                    if (d1 < 0 || d1 >= 128) v1 = -INFINITY;
                    s0[i] = v0; s1[i] = v1; smax = fmaxf(smax, fmaxf(v0, v1));
                }
                smax = fmaxf(smax, shfl_xor_l(smax, 32, lane));
                mn = fmaxf(m, smax);
            } else {
                if (MODE == 0 && key0 + 63 > qw) {
#pragma unroll
                    for (int i = 0; i < 16; ++i) { const int key = key0 + (i & 3) + 8 * (i >> 2) + 4 * hh; if (key > qi) s0[i] = -INFINITY; if (key + 32 > qi) s1[i] = -INFINITY; }
                }
#pragma unroll
                for (int i = 0; i < 16; ++i) smax = fmaxf(smax, fmaxf(s0[i], s1[i]));
                smax = fmaxf(smax, shfl_xor_l(smax, 32, lane));
                mn = fmaxf(m, smax * c);
            }
            const bool grow = __builtin_amdgcn_ballot_w64(mn > m) != 0ull;
            float ls = 0.f;
            if (MODE == 1) {
#pragma unroll
                for (int i = 0; i < 16; ++i) { const float p0 = __builtin_amdgcn_exp2f(s0[i] - mn), p1 = __builtin_amdgcn_exp2f(s1[i] - mn); s0[i] = p0; s1[i] = p1; ls += p0 + p1; }
            } else {
#pragma unroll
                for (int i = 0; i < 16; ++i) { const float p0 = __builtin_amdgcn_exp2f(fmaf(s0[i], c, -mn)), p1 = __builtin_amdgcn_exp2f(fmaf(s1[i], c, -mn)); s0[i] = p0; s1[i] = p1; ls += p0 + p1; }
            }
            if (grow) {
                const float alpha = __builtin_amdgcn_exp2f(m - mn);
                l *= alpha;
#pragma unroll
                for (int i = 0; i < 16; ++i) { o0[i] *= alpha; o1[i] *= alpha; }
                m = mn;
            }
            l += ls;
            bf16x8 pb[4];
#pragma unroll
            for (int g = 0; g < 2; ++g) {
                u32x4 w0, w1;
                w0.x = cvtpk(s0[8 * g + 0], s0[8 * g + 1]); w0.y = cvtpk(s0[8 * g + 2], s0[8 * g + 3]); w0.z = cvtpk(s0[8 * g + 4], s0[8 * g + 5]); w0.w = cvtpk(s0[8 * g + 6], s0[8 * g + 7]);
                w1.x = cvtpk(s1[8 * g + 0], s1[8 * g + 1]); w1.y = cvtpk(s1[8 * g + 2], s1[8 * g + 3]); w1.z = cvtpk(s1[8 * g + 4], s1[8 * g + 5]); w1.w = cvtpk(s1[8 * g + 6], s1[8 * g + 7]);
                pb[g] = __builtin_bit_cast(bf16x8, w0); pb[2 + g] = __builtin_bit_cast(bf16x8, w1);
            }
#pragma unroll
            for (int g = 0; g < 4; ++g) {
                const bf16x8 v0f = *(const LAS bf16x8*)(kb + vfrag_off + g * 32);
                const bf16x8 v1f = *(const LAS bf16x8*)(kb + vfrag_off + 32 * VROW + g * 32);
                o0 = __builtin_amdgcn_mfma_f32_32x32x16_bf16(v0f, pb[g], o0, 0, 0, 0);
                o1 = __builtin_amdgcn_mfma_f32_32x32x16_bf16(v1f, pb[g], o1, 0, 0, 0);
            }
        }
        if (has_next) ATT_STORE(cur ^ 1);
        __syncthreads();
    }
#undef ATT_LOAD
#undef ATT_STORE
    l += shfl_xor_l(l, 32, lane);
    if (MODE == 1) l += __builtin_amdgcn_exp2f(sinkl - m);
    const float inv = 1.0f / l;
    GAS bf16_t* op = O + (size_t)qi * ldo + 4 * hh;
#pragma unroll
    for (int g = 0; g < 4; ++g) {
        u32x2 w0, w1;
        w0.x = cvtpk(o0[4 * g + 0] * inv, o0[4 * g + 1] * inv); w0.y = cvtpk(o0[4 * g + 2] * inv, o0[4 * g + 3] * inv);
        w1.x = cvtpk(o1[4 * g + 0] * inv, o1[4 * g + 1] * inv); w1.y = cvtpk(o1[4 * g + 2] * inv, o1[4 * g + 3] * inv);
        *(GAS u32x2*)(op + 8 * g) = w0; *(GAS u32x2*)(op + 32 + 8 * g) = w1;
    }
}
}

__device__ __forceinline__ int launder_v(int v) { asm volatile("" : "+v"(v)); return v; }
__device__ __forceinline__ int opaque_zero() { int z; asm volatile("v_mov_b32 %0, 0" : "=v"(z)); return __builtin_amdgcn_readfirstlane(z); }
typedef const char __attribute__((address_space(4)))* kargp_t;
__device__ __forceinline__ unsigned long long opaque_u64(unsigned long long v) {
    const int lo_s = (int)(unsigned)v, hi_s = (int)(unsigned)(v >> 32); int lo, hi;
    asm volatile("v_mov_b32 %0, %2\n\tv_mov_b32 %1, %3" : "=&v"(lo), "=&v"(hi) : "s"(lo_s), "s"(hi_s));
    return ((unsigned long long)(unsigned)__builtin_amdgcn_readfirstlane(hi) << 32) | (unsigned long long)(unsigned)__builtin_amdgcn_readfirstlane(lo);
}
__device__ __forceinline__ const void* ld_arg(kargp_t kp, int byte_off) {
    return *(const void* const __attribute__((address_space(4)))*)(kp + byte_off);
}
#define INP(i) ((const float*)ld_arg(kp, 8 * (i)))
#define COS ((float*)(ws + WS_COS))
#define SIN ((float*)(ws + WS_SIN))
#define MEMN ((bf16_t*)(ws + WS_MEMN))
#define MEMK ((bf16_t*)(ws + WS_MEMK))
#define MEMVT ((bf16_t*)(ws + WS_MEMVT))
#define W_IN ((bf16_t*)(ws + WS_W_IN))
#define W_UQ ((bf16_t*)(ws + WS_W_UQ))
#define W_UK ((bf16_t*)(ws + WS_W_UK))
#define W_UV ((bf16_t*)(ws + WS_W_UV))
#define W_V ((bf16_t*)(ws + WS_W_V))
#define W_MK ((bf16_t*)(ws + WS_W_MK))
#define W_MV ((bf16_t*)(ws + WS_W_MV))
#define W_O ((bf16_t*)(ws + WS_W_O))
#define W_UP ((bf16_t*)(ws + WS_W_UP))
#define W_DN ((bf16_t*)(ws + WS_W_DN))
#define HN ((bf16_t*)(ws + WS_HN))
#define ABUF ((bf16_t*)(ws + WS_ABUF))
#define PROJ ((bf16_t*)(ws + WS_PROJ))
#define QB ((bf16_t*)(ws + WS_Q))
#define KN ((bf16_t*)(ws + WS_KN))
#define VT ((bf16_t*)(ws + WS_VT))
#define ATT ((bf16_t*)(ws + WS_ATT))
#define CQN ((bf16_t*)(ws + WS_CQN))
#define CKVN ((bf16_t*)(ws + WS_CKVN))
#define KROPE ((bf16_t*)(ws + WS_KROPE))
#define x_in INP(0)
#define mem INP(1)
#define positions ((const int*)ld_arg(kp, 16))
#define attn_norm_g INP(3)
#define mlp_norm_g INP(4)
#define mem_norm_g INP(5)
#define final_norm_g INP(6)
#define mla_w_in INP(7)
#define mla_q_norm_g INP(8)
#define mla_kv_norm_g INP(9)
#define mla_w_uq INP(10)
#define mla_w_ukv INP(11)
#define swa_w_in INP(12)
#define swa_sinks INP(13)
#define w_mem_kv INP(14)
#define w_o INP(15)
#define mlp_w_up INP(16)
#define mlp_w_down INP(17)
#define xres ((float*)ld_arg(kp, 144))

struct Args { const void* in[18]; float* out; unsigned char* ws; int ph_lo, ph_hi; };
constexpr int N_PHASES = 33;

__global__ void __launch_bounds__(NWAVES * 64, 2) trunk_fwd(Args args) {
    extern __shared__ __attribute__((aligned(16))) unsigned char lds_raw[];
    LAS unsigned char* lds = (LAS unsigned char*)lds_raw;
    volatile LAS unsigned* MISC = (volatile LAS unsigned*)(lds + MISC_OFF);
    unsigned* ctl = (unsigned*)(args.ws + WS_CTL);
    const int wave0 = __builtin_amdgcn_readfirstlane(threadIdx.x >> 6);
    for (int u = threadIdx.x; u < (LDS_BYTES - LDSCTL_OFF) / 4; u += NWAVES * 64) ((LAS unsigned*)(lds + LDSCTL_OFF))[u] = 0u;
    __syncthreads();
    unsigned bar_x = 0; (void)bar_x;
#if !MK_PER_PHASE_LAUNCH
    { XcdBarrier b0_ = xcd_barrier_post(ctl + CW_BAR, MISC + 8); bar_x = b0_.x; }
#endif
    const int lo = args.ph_lo, hi = args.ph_hi;
    int ph = 0;

#define PHASE_BEGIN if (ph >= lo && ph < hi) { const int zz = opaque_zero(); unsigned char* ws = (unsigned char*)opaque_u64((unsigned long long)args.ws); \
        kargp_t kp = (kargp_t)opaque_u64((unsigned long long)__builtin_amdgcn_kernarg_segment_ptr()); (void)kp; \
        const int tid = wave0 * 64 + lane_id_opaque(); \
        const int G = (int)gridDim.x + zz, bx = (int)blockIdx.x + zz, vcu = (G % 8 == 0) ? (bx % 8) * (G / 8) + bx / 8 : bx, NGW = G * NWAVES; (void)NGW; const int lane = tid & 63, wave = __builtin_amdgcn_readfirstlane(tid >> 6); \
        const int gw = vcu * NWAVES + wave; LAS float* scr = (LAS float*)(lds + wave * 16384); (void)ws; (void)lane; (void)gw; (void)scr;
#if MK_PER_PHASE_LAUNCH
#define PHASE_END } ++ph;
#else
#define PHASE_END if (ph + 1 < hi) { XcdBarrier b_; b_.bar = (unsigned*)ws + CW_BAR; b_.x = bar_x + (unsigned)zz; b_.st = MISC + 8; xcd_barrier(b_); } } ++ph;
#endif
#define CONVERT_LAYER(L) do { const int L_ = (L); const int j_ = L_ >> 1; const bool mla_ = (L_ & 1) == 0; \
        const int total_ = (mla_ ? (16 * 29 + 6 * 36 + 4 * 24 + 4 * 24) : (16 * 32 + 16 * 8 + 16 * 8)) + 16 * 8 + 16 * 8 + 16 * 32 + 16 * 128 + 64 * 32; \
        for (int it_ = gw; it_ < total_; it_ += NGW) { int r_ = it_; \
            if (mla_) { \
                if (conv_job(r_, mla_w_in + (size_t)j_ * 1024 * 928, 928, 1024, 0, 0, 928, W_IN, 0, scr, lane)) continue; \
                if (conv_job(r_, mla_w_uq + (size_t)j_ * 384 * 1152, 1152, 384, 0, 0, 1152, W_UQ, 0, scr, lane)) continue; \
                if (conv_job(r_, mla_w_ukv + (size_t)j_ * 256 * 1536, 1536, 256, 0, 1, 768, W_UK, 0, scr, lane)) continue; \
                if (conv_job(r_, mla_w_ukv + (size_t)j_ * 256 * 1536, 1536, 256, 64, 1, 768, W_UV, 0, scr, lane)) continue; \
            } else { \
                if (conv_job(r_, swa_w_in + (size_t)j_ * 1024 * 1536, 1536, 1024, 0, 0, 1024, W_IN, 0, scr, lane)) continue; \
                if (conv_job(r_, swa_w_in + (size_t)j_ * 1024 * 1536, 1536, 1024, 1280, 0, 256, W_IN, 1024, scr, lane)) continue; \
                if (conv_job(r_, swa_w_in + (size_t)j_ * 1024 * 1536, 1536, 1024, 1024, 0, 256, W_V, 0, scr, lane)) continue; \
            } \
            if (conv_job(r_, w_mem_kv + (size_t)L_ * 1024 * 512, 512, 1024, 0, 0, 256, W_MK, 0, scr, lane)) continue; \
            if (conv_job(r_, w_mem_kv + (size_t)L_ * 1024 * 512, 512, 1024, 256, 0, 256, W_MV, 0, scr, lane)) continue; \
            if (conv_job(r_, w_o + (size_t)L_ * 1024 * 1024, 1024, 1024, 0, 0, 1024, W_O, 0, scr, lane)) continue; \
            if (conv_job(r_, mlp_w_up + (size_t)L_ * 1024 * 4096, 4096, 1024, 0, 0, 4096, W_UP, 0, scr, lane)) continue; \
            (void)conv_job(r_, mlp_w_down + (size_t)L_ * 4096 * 1024, 1024, 4096, 0, 0, 1024, W_DN, 0, scr, lane); \
        } } while (0)

    PHASE_BEGIN
        for (int i = bx * (NWAVES * 64) + tid; i < T * 16; i += G * NWAVES * 64) {
            const int t = i >> 4, f = i & 15; const float ang = (float)positions[t] * rope_inv[f];
            float sn, cs; sincos_acc(ang, sn, cs); COS[i] = cs; SIN[i] = sn;
        }
        for (int rr = gw; rr < NB * NMEM; rr += NGW) rms_row_bf16(mem + (size_t)rr * D, mem_norm_g, MEMN + (size_t)rr * D, lane);
        CONVERT_LAYER(0);
        for (int rr = gw; rr < T; rr += NGW) rms_row_bf16(x_in + (size_t)rr * D, attn_norm_g, HN + (size_t)rr * D, lane);
    PHASE_END

    for (int L = 0; L < DEPTH; ++L) {
        const bool mla = (L & 1) == 0; const int j = L >> 1;
        PHASE_BEGIN
            { pg8::Gemm g{HN, W_IN, T, mla ? 1024 : 1280, 1024, 1024, 1024}; pg8::StaticOrder So; So.init(g.M, g.N, G, bx, 0);
              pg8::EpiBf16<0> E{PROJ, PROJ_LD}; pg8::gemm_phase(lds, g, So, E, wave0); }
            if (!mla) {
                int rot = (T / 256) * 5;
                { pg8::Gemm g{W_V, HN, 256, T, 1024, 1024, 1024}; pg8::StaticOrder So; So.init(g.M, g.N, G, bx, rot); rot += 64;
                  pg8::EpiBf16<0> E{VT, T}; pg8::gemm_phase(lds, g, So, E, wave0); }
                { pg8::Gemm g{MEMN, W_MK, 1024, 256, 1024, 1024, 1024}; pg8::StaticOrder So; So.init(g.M, g.N, G, bx, rot); rot += 4;
                  pg8::EpiBf16<0> E{MEMK, 256}; pg8::gemm_phase(lds, g, So, E, wave0); }
                { pg8::Gemm g{W_MV, MEMN, 256, 1024, 1024, 1024, 1024}; pg8::StaticOrder So; So.init(g.M, g.N, G, bx, rot);
                  pg8::EpiBf16<0> E{MEMVT, 1024}; pg8::gemm_phase(lds, g, So, E, wave0); }
            }
        PHASE_END
        if (mla) {
            PHASE_BEGIN
                const float* gq = mla_q_norm_g + j * 384; const float* gkv = mla_kv_norm_g + j * 256;
                for (int t = gw; t < T; t += NGW) {
                    const bf16_t* pr = PROJ + (size_t)t * PROJ_LD;
                    const u32x2 a = *(const u32x2*)(pr + 4 * lane);
                    u32x2 b = {0u, 0u}; if (lane < 32) b = *(const u32x2*)(pr + 256 + 4 * lane);
                    const u32x2 kv = *(const u32x2*)(pr + 384 + 4 * lane);
                    const float a0 = bf2f(a.x & 0xffffu), a1 = bf2f(a.x >> 16), a2 = bf2f(a.y & 0xffffu), a3 = bf2f(a.y >> 16);
                    const float b0 = bf2f(b.x & 0xffffu), b1 = bf2f(b.x >> 16), b2 = bf2f(b.y & 0xffffu), b3 = bf2f(b.y >> 16);
                    const float k0 = bf2f(kv.x & 0xffffu), k1 = bf2f(kv.x >> 16), k2 = bf2f(kv.y & 0xffffu), k3 = bf2f(kv.y >> 16);
                    const float sq = wave_sum((a0 * a0 + a1 * a1) + (a2 * a2 + a3 * a3) + (b0 * b0 + b1 * b1) + (b2 * b2 + b3 * b3), lane);
                    const float skv = wave_sum((k0 * k0 + k1 * k1) + (k2 * k2 + k3 * k3), lane);
                    const float rq = 1.0f / sqrtf(sq * (1.0f / 384.0f) + EPS), rkv = 1.0f / sqrtf(skv * (1.0f / 256.0f) + EPS);
                    { const f32x4 gv = *(const f32x4*)(gq + 4 * lane); u32x2 w; w.x = pk2(a0 * rq * gv.x, a1 * rq * gv.y); w.y = pk2(a2 * rq * gv.z, a3 * rq * gv.w);
                      *(u32x2*)(CQN + (size_t)t * 384 + 4 * lane) = w; }
                    if (lane < 32) { const f32x4 gv = *(const f32x4*)(gq + 256 + 4 * lane); u32x2 w; w.x = pk2(b0 * rq * gv.x, b1 * rq * gv.y); w.y = pk2(b2 * rq * gv.z, b3 * rq * gv.w);
                      *(u32x2*)(CQN + (size_t)t * 384 + 256 + 4 * lane) = w; }
                    { const f32x4 gv = *(const f32x4*)(gkv + 4 * lane); u32x2 w; w.x = pk2(k0 * rkv * gv.x, k1 * rkv * gv.y); w.y = pk2(k2 * rkv * gv.z, k3 * rkv * gv.w);
                      *(u32x2*)(CKVN + (size_t)t * 256 + 4 * lane) = w; }
                    if (lane < 16) { const float x1 = bf2f(pr[640 + lane]), x2 = bf2f(pr[656 + lane]); const float cs = COS[(size_t)t * 16 + lane], sn = SIN[(size_t)t * 16 + lane];
                      KROPE[(size_t)t * 32 + lane] = (bf16_t)f2bf(x1 * cs - x2 * sn); KROPE[(size_t)t * 32 + 16 + lane] = (bf16_t)f2bf(x1 * sn + x2 * cs); }
                }
            PHASE_END
            PHASE_BEGIN
                int rot = 0;
                { pg8::Gemm g{CQN, W_UQ, T, 1280, 384, 384, 384}; pg8::StaticOrder So; So.init(g.M, g.N, G, bx, rot); rot += 64 * 5;
                  pg8::EpiRope E{QB, QLD, COS, SIN}; pg8::gemm_phase(lds, g, So, E, wave0); }
                { pg8::Gemm g{CKVN, W_UK, T, 768, 256, 256, 256}; pg8::StaticOrder So; So.init(g.M, g.N, G, bx, rot); rot += 64 * 3;
                  pg8::EpiBf16<0> E{KN, 768}; pg8::gemm_phase(lds, g, So, E, wave0); }
                { pg8::Gemm g{W_UV, CKVN, 768, T, 256, 256, 256}; pg8::StaticOrder So; So.init(g.M, g.N, G, bx, rot); rot += 64 * 3;
                  pg8::EpiBf16<0> E{VT, T}; pg8::gemm_phase(lds, g, So, E, wave0); }
                { pg8::Gemm g{MEMN, W_MK, 1024, 256, 1024, 1024, 1024}; pg8::StaticOrder So; So.init(g.M, g.N, G, bx, rot); rot += 4;
                  pg8::EpiBf16<0> E{MEMK, 256}; pg8::gemm_phase(lds, g, So, E, wave0); }
                { pg8::Gemm g{W_MV, MEMN, 256, 1024, 1024, 1024, 1024}; pg8::StaticOrder So; So.init(g.M, g.N, G, bx, rot);
                  pg8::EpiBf16<0> E{MEMVT, 1024}; pg8::gemm_phase(lds, g, So, E, wave0); }
            PHASE_END
        }
        PHASE_BEGIN
            for (int rep_ = 0; rep_ < PROBE_ATT_REPS; ++rep_) {
            unsigned* qctr = (unsigned*)ws + CW_ATTQ + 64 * (L * 2 + rep_);
            volatile LAS int* slot = (volatile LAS int*)(lds + att::SLOT_OFF);
            if (tid == 0) slot[0] = (int)__hip_atomic_fetch_add(qctr, 1u, __ATOMIC_RELAXED, __HIP_MEMORY_SCOPE_AGENT);
            __syncthreads();
            for (;;) {
                const int u = slot[0];
                __syncthreads();
                if (u >= 1024) break;
                int nxt = 0; if (tid == 0) nxt = (int)__hip_atomic_fetch_add(qctr, 1u, __ATOMIC_RELAXED, __HIP_MEMORY_SCOPE_AGENT);
                const GAS bf16_t* gPROJ = (const GAS bf16_t*)PROJ; GAS bf16_t* gATT = (GAS bf16_t*)ATT; const GAS bf16_t* gVT = (const GAS bf16_t*)VT;
                if (u < 768) {
                    const int qb = 15 - u / 48, bh = u % 48, b = bh / 12, h = bh % 12; const int q0 = qb * 256; const size_t rb = (size_t)b * S;
                    if (mla) {
                        att::attn_unit<96, 0>(lds, (const GAS bf16_t*)QB + rb * QLD + h * 96, QLD, (const GAS bf16_t*)KN + rb * 768 + h * 64, 768, (const GAS bf16_t*)KROPE + rb * 32, gVT + (size_t)(h * 64) * T + rb, T,
                                              gATT + rb * 1024 + h * 64, 1024, q0, 0, (q0 + 256) / 64, 0.10206207261596577f * LOG2E, 0.f, 0.f, (const GAS int*)positions, tid);
                    } else {
                        const int kvh = h / 3; const float slope = __builtin_amdgcn_exp2f(-(float)(h + 1) * (8.0f / 12.0f)) * LOG2E;
                        const float sinkl = swa_sinks[j * 12 + h] * LOG2E; const int t_lo = (q0 - 128) / 64 > 0 ? (q0 - 128) / 64 : 0;
                        att::attn_unit<64, 1>(lds, gPROJ + rb * PROJ_LD + h * 64, PROJ_LD, gPROJ + rb * PROJ_LD + 768 + kvh * 64, PROJ_LD, nullptr, gVT + (size_t)(kvh * 64) * T + rb, T,
                                              gATT + rb * 1024 + h * 64, 1024, q0, t_lo, (q0 + 256) / 64, 0.125f * LOG2E, slope, sinkl, (const GAS int*)positions + rb, tid);
                    }
                } else {
                    const int v = u - 768, qb = v / 16, bh = v % 16, b = bh / 4, hc = bh % 4; const int q0 = qb * 256; const size_t rb = (size_t)b * S;
                    const int qc_off = mla ? 672 : 1024;
                    att::attn_unit<64, 2>(lds, gPROJ + rb * PROJ_LD + qc_off + hc * 64, PROJ_LD, (const GAS bf16_t*)MEMK + (size_t)(b * NMEM) * 256 + hc * 64, 256, nullptr, (const GAS bf16_t*)MEMVT + (size_t)(hc * 64) * 1024 + b * NMEM, 1024,
                                          gATT + rb * 1024 + 768 + hc * 64, 1024, q0, 0, NMEM / 64, 0.125f * LOG2E, 0.f, 0.f, (const GAS int*)positions, tid);
                }
                if (tid == 0) slot[0] = nxt;
                __syncthreads();
            }
            }
        PHASE_END
        PHASE_BEGIN
            { pg8::Gemm g{ATT, W_O, T, 1024, 1024, 1024, 1024}; pg8::StaticOrder So; So.init(g.M, g.N, G, bx, 0);
              pg8::EpiRes E{L == 0 ? x_in : xres, xres, D}; pg8::gemm_phase(lds, g, So, E, wave0); }
        PHASE_END
        PHASE_BEGIN
            for (int rr = gw; rr < T; rr += NGW) rms_row_bf16(xres + (size_t)rr * D, mlp_norm_g + L * D, HN + (size_t)rr * D, lane);
        PHASE_END
        PHASE_BEGIN
            { pg8::Gemm g{HN, W_UP, T, FF, 1024, 1024, 1024}; pg8::StaticOrder So; So.init(g.M, g.N, G, bx, 0);
              pg8::EpiBf16<1> E{ABUF, FF}; pg8::gemm_phase(lds, g, So, E, wave0); }
        PHASE_END
        PHASE_BEGIN
            { pg8::Gemm g{ABUF, W_DN, T, 1024, FF, FF, FF}; pg8::StaticOrder So; So.init(g.M, g.N, G, bx, 0);
              pg8::EpiRes E{xres, xres, D}; pg8::gemm_phase(lds, g, So, E, wave0); }
        PHASE_END
        PHASE_BEGIN
            if (L + 1 < DEPTH) {
                CONVERT_LAYER(L + 1);
                for (int rr = gw; rr < T; rr += NGW) rms_row_bf16(xres + (size_t)rr * D, attn_norm_g + (L + 1) * D, HN + (size_t)rr * D, lane);
            } else {
                for (int rr = gw; rr < T; rr += NGW) rms_row_f32(xres + (size_t)rr * D, final_norm_g, xres + (size_t)rr * D, lane);
            }
        PHASE_END
    }
#undef PHASE_BEGIN
#undef PHASE_END
#undef CONVERT_LAYER
}

extern "C" void kernel_launch(void* const* d_in, const int* in_sizes, int n_in, void* d_out, int out_size, void* d_ws, size_t ws_size, hipStream_t stream) {
    static int grid = 0;
    if (grid == 0) {
        if (n_in != 18 || out_size != T * D || ws_size < WS_END) { fprintf(stderr, "kernel_launch: unexpected shapes (n_in %d out %d ws %zu)\n", n_in, out_size, ws_size); grid = -1; return; }
        int dev = 0, cus = 0, per_cu = 0;
        if (hipGetDevice(&dev) != hipSuccess || hipDeviceGetAttribute(&cus, hipDeviceAttributeMultiprocessorCount, dev) != hipSuccess) { grid = -1; return; }
        if (hipFuncSetAttribute((const void*)trunk_fwd, hipFuncAttributeMaxDynamicSharedMemorySize, LDS_BYTES) != hipSuccess) { fprintf(stderr, "kernel_launch: hipFuncSetAttribute failed\n"); grid = -1; return; }
        if (hipOccupancyMaxActiveBlocksPerMultiprocessor(&per_cu, (const void*)trunk_fwd, NWAVES * 64, LDS_BYTES) != hipSuccess || per_cu < 1)
            fprintf(stderr, "kernel_launch: occupancy query reports %d blocks per CU\n", per_cu);
        (void)hipGetLastError();
        grid = cus;
    }
    if (grid < 0) return;
    (void)hipMemsetAsync((char*)d_ws + WS_CTL, 0, CTL_ZERO_BYTES, stream);
    Args a{};
    for (int i = 0; i < 18; ++i) a.in[i] = d_in[i];
    a.out = (float*)d_out; a.ws = (unsigned char*)d_ws;
#if MK_PER_PHASE_LAUNCH
    for (int p = 0; p < N_PHASES; ++p) { a.ph_lo = p; a.ph_hi = p + 1; hipLaunchKernelGGL(trunk_fwd, dim3(grid), dim3(NWAVES * 64), LDS_BYTES, stream, a); }
#else
    a.ph_lo = 0; a.ph_hi = N_PHASES;
    hipLaunchKernelGGL(trunk_fwd, dim3(grid), dim3(NWAVES * 64), LDS_BYTES, stream, a);
#endif
}
```

```cpp
#include <hip/hip_runtime.h>
#include <cstdio>
#include <cstdint>

#ifndef MK_PER_PHASE_LAUNCH
#define MK_PER_PHASE_LAUNCH 0
#endif

#define LAS __attribute__((address_space(3)))
#define GAS __attribute__((address_space(1)))
typedef unsigned short bf16_t;
typedef short bf16x8 __attribute__((ext_vector_type(8)));
typedef short s16x4 __attribute__((ext_vector_type(4)));
typedef float f32x2 __attribute__((ext_vector_type(2)));
typedef float f32x4 __attribute__((ext_vector_type(4)));
typedef float f32x16 __attribute__((ext_vector_type(16)));
typedef unsigned u32x2 __attribute__((ext_vector_type(2)));
typedef unsigned u32x4 __attribute__((ext_vector_type(4)));
typedef __bf16 bf16x2_t __attribute__((ext_vector_type(2)));

constexpr int NB = 4, S = 4096, T = NB * S, D = 1024, FF = 4096, NMEM = 256, DEPTH = 4;
constexpr int PROJ_LD = 1280;
constexpr int QLD = 1280;
constexpr float EPS = 1e-6f;
constexpr float LOG2E = 1.4426950408889634f;
constexpr float QS_MLA = 0.10206207261596577f * LOG2E, QS_64 = 0.125f * LOG2E;
constexpr float RESCALE_THR = 8.0f;

constexpr size_t MiB = 1u << 20;
constexpr size_t WS_CTL = 0, CTL_ZERO_BYTES = 128 * 1024;
constexpr size_t WS_COS = 1 * MiB, WS_SIN = 2 * MiB;
constexpr size_t WS_MEMN = 3 * MiB;
constexpr size_t WS_MEMK = 5 * MiB, WS_MEMVT = 5 * MiB + 512 * 1024;
constexpr size_t WS_SSQ = 6 * MiB;
constexpr size_t WS_SSQA = 9 * MiB;
constexpr size_t WS_SSQ32 = 7 * MiB;
constexpr size_t WS_WSET = 10 * MiB, WSET_BYTES = 25 * MiB;
constexpr size_t WO_IN = 0;
constexpr size_t WO_UQ = 5 * MiB / 2;
constexpr size_t WO_UK = 7 * MiB / 2, WO_UV = 4 * MiB;
constexpr size_t WO_V = 9 * MiB / 2;
constexpr size_t WO_MK = 5 * MiB, WO_MV = 11 * MiB / 2;
constexpr size_t WO_O = 6 * MiB;
constexpr size_t WO_UP = 8 * MiB;
constexpr size_t WO_DN = 16 * MiB;
constexpr size_t WS_XB = 60 * MiB;
constexpr size_t WS_ABUF = 92 * MiB;
constexpr size_t WS_PROJ = 92 * MiB;
constexpr size_t WS_Q = 132 * MiB;
constexpr size_t WS_KN = 172 * MiB;
constexpr size_t WS_VT = 196 * MiB;
constexpr size_t WS_ATT = 220 * MiB;
constexpr size_t WS_END = 252 * MiB;
constexpr int CW_ATTQ = 16384;
constexpr int CW_BAR = 4096;

constexpr int RING_BYTES = 131072;
constexpr int LDSCTL_OFF = RING_BYTES, MISC_OFF = LDSCTL_OFF + 320;
constexpr int LDS_BYTES = 147456;
constexpr int NWAVES = 8;

__device__ const float rope_inv[16] = {1.0f, 0.5623413251903491f, 0.31622776601683794f, 0.1778279410038923f, 0.1f, 0.05623413251903491f,
    0.03162277660168379f, 0.01778279410038923f, 0.01f, 0.005623413251903491f, 0.0031622776601683794f, 0.0017782794100389228f, 0.001f,
    0.0005623413251903491f, 0.00031622776601683794f, 0.00017782794100389227f};

__device__ __forceinline__ unsigned f2bf(float f) { unsigned u = __builtin_bit_cast(unsigned, f); return (u + 0x7fffu + ((u >> 16) & 1u)) >> 16; }
__device__ __forceinline__ unsigned pk2(float lo, float hi) { return f2bf(lo) | (f2bf(hi) << 16); }
__device__ __forceinline__ float bf2f(unsigned b) { return __builtin_bit_cast(float, b << 16); }
__device__ __forceinline__ unsigned cvtpk(float lo, float hi) { f32x2 v = {lo, hi}; bf16x2_t b = __builtin_convertvector(v, bf16x2_t); return __builtin_bit_cast(unsigned, b); }
#define LDS_WAIT() asm volatile("s_waitcnt lgkmcnt(0)" ::: "memory")
#define VM_WAIT() asm volatile("s_waitcnt vmcnt(0)" ::: "memory")
__device__ __forceinline__ float shfl_xor_l(float v, int o, int lane) { return __builtin_bit_cast(float, __builtin_amdgcn_ds_bpermute((lane ^ o) << 2, __builtin_bit_cast(int, v))); }
__device__ __forceinline__ float wave_sum(float v, int lane) {
#pragma unroll
    for (int o = 1; o < 64; o <<= 1) v += shfl_xor_l(v, o, lane);
    return v;
}
__device__ __forceinline__ float fadd_s(float a, float b) { float r; asm("v_add_f32 %0, %1, %2" : "=v"(r) : "v"(a), "v"(b)); return r; }
__device__ __forceinline__ int lane_id_opaque() { int l; asm volatile("v_mbcnt_lo_u32_b32 %0, -1, 0\n\tv_mbcnt_hi_u32_b32 %0, -1, %0" : "=v"(l)); return l; }

template <int FN> __device__ __forceinline__ float row_rs(const GAS float* ssq, int row) {
    if (FN == 0) { const GAS f32x4* p = (const GAS f32x4*)(ssq + (size_t)row * 16); const f32x4 a = p[0], b = p[1], c = p[2], d = p[3];
        const float s = ((a.x + a.y) + (a.z + a.w)) + ((b.x + b.y) + (b.z + b.w)) + ((c.x + c.y) + (c.z + c.w)) + ((d.x + d.y) + (d.z + d.w)); return __builtin_amdgcn_rsqf(s * (1.0f / 1024.0f) + EPS); }
    if (FN == 1) { const GAS f32x4* p = (const GAS f32x4*)(ssq + (size_t)row * 32); const f32x4 a = p[0], b = p[1], c = p[2];
        const float s = ((a.x + a.y) + (a.z + a.w)) + ((b.x + b.y) + (b.z + b.w)) + ((c.x + c.y) + (c.z + c.w)); return __builtin_amdgcn_rsqf(s * (1.0f / 384.0f) + EPS); }
    const GAS f32x4* p = (const GAS f32x4*)(ssq + (size_t)row * 32 + 12); const f32x4 a = p[0], b = p[1];
    const float s = ((a.x + a.y) + (a.z + a.w)) + ((b.x + b.y) + (b.z + b.w)); return __builtin_amdgcn_rsqf(s * (1.0f / 256.0f) + EPS);
}

namespace pg8 {
constexpr int BM = 256, BK = 64, HALF = 128, HTB = HALF * BK * 2, STAGE_BYTES = 8 * HTB, NXCD = 8, WGM = 8;
__host__ __device__ __forceinline__ int lds_byte(int r, int c) { const int st = (r >> 4) * 2 + (c >> 5), rr = r & 15, cc = c & 31, ob = rr * 64 + cc * 2; return st * 1024 + (ob ^ (((ob >> 9) & 1) << 5)); }
__host__ __device__ __forceinline__ void stage_rc(int b, int& R, int& C) { const int st = b / 1024, sb = b % 1024, swz = sb ^ (((sb >> 9) & 1) << 5); R = (st >> 1) * 16 + swz / 64; C = (st & 1) * 32 + (swz % 64) / 2; }
__host__ __device__ __forceinline__ int perm32(int rho) { const int n = rho >> 4, i = rho & 15; return 8 * (i >> 2) + 4 * n + (i & 3); }

struct Unit { int pm, pn; };
struct Gemm { const GAS bf16_t* A; const GAS bf16_t* Bt; int M, N, K, lda, ldb; };

struct StaticOrder {
    int nM, nN, nwg, G, c;
    __device__ void init(int M, int N, int G_, int c_, int rot) { nM = M / BM; nN = N / BM; nwg = nM * nN; G = G_; c = (c_ + G_ - (rot % G_)) % G_; }
    __device__ bool next(int i, Unit& u) const {
        const long L = (long)i * G + c; if (L >= nwg) return false;
        int wgid = (int)L; { const int q = nwg / NXCD, r = nwg % NXCD, xcd = wgid % NXCD, off = wgid / NXCD; wgid = (xcd < r ? xcd * (q + 1) : r * (q + 1) + (xcd - r) * q) + off; }
        const int nig = WGM * nN, gid = wgid / nig, fm = gid * WGM, gsz = (nM - fm) < WGM ? (nM - fm) : WGM;
        u.pm = fm + ((wgid % nig) % gsz); u.pn = (wgid % nig) / gsz; return true;
    }
};

__device__ __forceinline__ unsigned cvt_pk_bf16(float lo, float hi) { unsigned r; asm volatile("v_cvt_pk_bf16_f32 %0, %1, %2" : "=v"(r) : "v"(lo), "v"(hi)); return r; }

template <int ACT  , int AXIS, int FN, bool VTL = false, bool QSC = false> struct EpiBf16 {
    static constexpr bool PERM = true;
    GAS bf16_t* O; int ldc; const GAS float* ssq;
    __device__ __forceinline__ void operator()(const f32x4 (&acc)[2][2][4][2], const Unit& u, int wr, int wc, int fr, int fq) const {
        const int row0 = u.pm * BM + wr * 64 + fr; const int col0 = u.pn * BM + wc * 32 + 8 * fq;
        float cs[2][8];
        if (AXIS == 2) {
#pragma unroll
            for (int bj = 0; bj < 2; ++bj)
#pragma unroll
                for (int k = 0; k < 8; ++k) cs[bj][k] = row_rs<FN>(ssq, col0 + bj * HALF + k);
        }
#pragma unroll
        for (int ai = 0; ai < 2; ++ai)
#pragma unroll
            for (int m = 0; m < 4; ++m) { const int row = row0 + ai * HALF + m * 16;
                GAS bf16_t* rowp = VTL ? O + ((size_t)(col0 >> 6) * ldc + row) * 64 + (col0 & 63) : O + (size_t)row * ldc + col0;
                float rs = 1.f; if (AXIS == 1) rs = row_rs<FN>(ssq, row);
#pragma unroll
                for (int bj = 0; bj < 2; ++bj) { f32x4 v0 = acc[ai][bj][m][0], v1 = acc[ai][bj][m][1];
                    if (AXIS == 1) { float rq = rs; if (QSC) { const int g32 = u.pn * 8 + bj * 4 + wc; rq = (g32 < 24 || g32 >= 32) ? rs * QS_64 : rs; } v0 = v0 * rq; v1 = v1 * rq; }
                    if (AXIS == 2) {
#pragma unroll
                        for (int e = 0; e < 4; ++e) { v0[e] *= cs[bj][e]; v1[e] *= cs[bj][4 + e]; } }
                    if (ACT == 1) {
#pragma unroll
                        for (int e = 0; e < 4; ++e) { const float a = fmaxf(v0[e], 0.f), b = fmaxf(v1[e], 0.f); v0[e] = a * a; v1[e] = b * b; } }
                    u32x4 w; w.x = cvt_pk_bf16(v0[0], v0[1]); w.y = cvt_pk_bf16(v0[2], v0[3]); w.z = cvt_pk_bf16(v1[0], v1[1]); w.w = cvt_pk_bf16(v1[2], v1[3]);
                    *(GAS u32x4*)(rowp + (VTL ? (size_t)bj * 2 * ldc * 64 : (size_t)bj * HALF)) = w; } }
    }
};
template <bool SCALED> struct EpiResNorm {
    static constexpr bool PERM = true;
    GAS bf16_t* xb; GAS float* ssq; const GAS float* ssq_in; int ldc;
    __device__ __forceinline__ void operator()(const f32x4 (&acc)[2][2][4][2], const Unit& u, int wr, int wc, int fr, int fq) const {
        const int row0 = u.pm * BM + wr * 64 + fr, col0 = u.pn * BM + wc * 32 + 8 * fq; const int lane = fq * 16 + fr;
#pragma unroll
        for (int ai = 0; ai < 2; ++ai)
#pragma unroll
            for (int m = 0; m < 4; ++m) { const int row = row0 + ai * HALF + m * 16; GAS bf16_t* rowp = xb + (size_t)row * ldc + col0; float part = 0.f;
                float r2 = 1.f;
                if (SCALED) { const GAS f32x4* p = (const GAS f32x4*)(ssq_in + (size_t)row * 16); const f32x4 a = p[0], b = p[1], c = p[2], d = p[3];
                    const float s = ((a.x + a.y) + (a.z + a.w)) + ((b.x + b.y) + (b.z + b.w)) + ((c.x + c.y) + (c.z + c.w)) + ((d.x + d.y) + (d.z + d.w)); r2 = __builtin_amdgcn_rcpf(s * (1.0f / 1024.0f) + EPS); }
#pragma unroll
                for (int bj = 0; bj < 2; ++bj) { const u32x4 old = *(const GAS u32x4*)(rowp + bj * HALF); f32x4 v0 = acc[ai][bj][m][0], v1 = acc[ai][bj][m][1];
                    if (SCALED) { v0 = v0 * r2; v1 = v1 * r2; }
                    const float x0 = bf2f(old.x & 0xffffu) + v0[0], x1 = bf2f(old.x >> 16) + v0[1], x2 = bf2f(old.y & 0xffffu) + v0[2], x3 = bf2f(old.y >> 16) + v0[3];
                    const float x4 = bf2f(old.z & 0xffffu) + v1[0], x5 = bf2f(old.z >> 16) + v1[1], x6 = bf2f(old.w & 0xffffu) + v1[2], x7 = bf2f(old.w >> 16) + v1[3];
                    u32x4 w; w.x = cvt_pk_bf16(x0, x1); w.y = cvt_pk_bf16(x2, x3); w.z = cvt_pk_bf16(x4, x5); w.w = cvt_pk_bf16(x6, x7);
                    *(GAS u32x4*)(rowp + bj * HALF) = w;
                    part += ((x0 * x0 + x1 * x1) + (x2 * x2 + x3 * x3)) + ((x4 * x4 + x5 * x5) + (x6 * x6 + x7 * x7)); }
                part += shfl_xor_l(part, 16, lane); part += shfl_xor_l(part, 32, lane);
                if (fq == 0) ssq[(size_t)row * 16 + u.pn * 4 + wc] = part; }
    }
};
struct EpiRope {
    static constexpr bool PERM = false;
    GAS bf16_t* O; int ldc; const GAS float* cs; const GAS float* sn; const GAS float* ssq32;
    __device__ __forceinline__ void operator()(const f32x4 (&acc)[2][2][4][2], const Unit& u, int wr, int wc, int fr, int fq) const {
        const int row0 = u.pm * BM + wr * 64 + fr;
#pragma unroll
        for (int ai = 0; ai < 2; ++ai)
#pragma unroll
            for (int m = 0; m < 4; ++m) { const int row = row0 + ai * HALF + m * 16; const float rs = row_rs<1>(ssq32, row) * QS_MLA;
                const f32x4 c = *(const GAS f32x4*)(cs + (size_t)row * 16 + 4 * fq), s = *(const GAS f32x4*)(sn + (size_t)row * 16 + 4 * fq);
#pragma unroll
                for (int bj = 0; bj < 2; ++bj) { const int cb = u.pn * BM + bj * HALF + wc * 32; const bool rope = ((cb >> 5) % 3) == 2;
                    f32x4 v0 = acc[ai][bj][m][0] * rs, v1 = acc[ai][bj][m][1] * rs;
                    if (rope) { const f32x4 a = v0 * c - v1 * s, b = v0 * s + v1 * c; v0 = a; v1 = b; }
                    u32x2 w0, w1; w0.x = cvt_pk_bf16(v0[0], v0[1]); w0.y = cvt_pk_bf16(v0[2], v0[3]); w1.x = cvt_pk_bf16(v1[0], v1[1]); w1.y = cvt_pk_bf16(v1[2], v1[3]);
                    GAS bf16_t* p = O + (size_t)row * ldc + cb + 4 * fq; *(GAS u32x2*)p = w0; *(GAS u32x2*)(p + 16) = w1; } }
    }
};
struct EpiProjMla {
    static constexpr bool PERM = false;
    GAS bf16_t* O; int ldc; const GAS float* ssq; GAS float* ssq32; const GAS float* cs; const GAS float* sn;
    __device__ __forceinline__ void operator()(const f32x4 (&acc)[2][2][4][2], const Unit& u, int wr, int wc, int fr, int fq) const {
        const int row0 = u.pm * BM + wr * 64 + fr; const int lane = fq * 16 + fr;
#pragma unroll
        for (int ai = 0; ai < 2; ++ai)
#pragma unroll
            for (int m = 0; m < 4; ++m) { const int row = row0 + ai * HALF + m * 16; const float rs = row_rs<0>(ssq, row);
#pragma unroll
                for (int bj = 0; bj < 2; ++bj) { const int g32 = u.pn * 8 + bj * 4 + wc; const int cb = g32 * 32;
                    f32x4 v0 = acc[ai][bj][m][0] * rs, v1 = acc[ai][bj][m][1] * rs;
                    if (g32 < 20) { float part = ((v0[0] * v0[0] + v0[1] * v0[1]) + (v0[2] * v0[2] + v0[3] * v0[3])) + ((v1[0] * v1[0] + v1[1] * v1[1]) + (v1[2] * v1[2] + v1[3] * v1[3]));
                        part += shfl_xor_l(part, 16, lane); part += shfl_xor_l(part, 32, lane);
                        if (fq == 0) ssq32[(size_t)row * 32 + g32] = part; }
                    if (g32 == 20) { const f32x4 c = *(const GAS f32x4*)(cs + (size_t)row * 16 + 4 * fq), s = *(const GAS f32x4*)(sn + (size_t)row * 16 + 4 * fq);
                        const f32x4 a = v0 * c - v1 * s, b = v0 * s + v1 * c; v0 = a; v1 = b; }
                    if (g32 > 20 && g32 < 29) { v0 = v0 * QS_64; v1 = v1 * QS_64; }
                    u32x2 w0, w1; w0.x = cvt_pk_bf16(v0[0], v0[1]); w0.y = cvt_pk_bf16(v0[2], v0[3]); w1.x = cvt_pk_bf16(v1[0], v1[1]); w1.y = cvt_pk_bf16(v1[2], v1[3]);
                    GAS bf16_t* p = O + (size_t)row * ldc + cb + 4 * fq; *(GAS u32x2*)p = w0; *(GAS u32x2*)(p + 16) = w1; } }
    }
};

template <class Epi>
__device__ __forceinline__ void gemm_phase(LAS unsigned char* lds, const Gemm g, const StaticOrder& S, const Epi& E, int wave_sgpr) {
    int tid; asm volatile("v_mbcnt_lo_u32_b32 %0, -1, 0\n\tv_mbcnt_hi_u32_b32 %0, -1, %0" : "=v"(tid)); tid += wave_sgpr * 64;
    const int wid = __builtin_amdgcn_readfirstlane(tid >> 6), lane = tid & 63, wr = wid >> 2, wc = wid & 3, fr = lane & 15, fq = lane >> 4;
    const int K = g.K, nt = K / BK;
    unsigned voffA[2], voffB[2];
#pragma unroll
    for (int i = 0; i < 2; ++i) { int R, C; stage_rc(tid * 16 + i * 8192, R, C); const int Rb = Epi::PERM ? ((R & ~31) + perm32(R & 31)) : R;
        voffA[i] = (unsigned)(R * g.lda + C) * 2u; voffB[i] = (unsigned)(Rb * g.ldb + C) * 2u; }
    const size_t kstep = (size_t)(BK * 2);
    const size_t hstepA = (size_t)HALF * g.lda * 2, hstepB = (size_t)HALF * g.ldb * 2;
    const size_t tstepA = 2 * hstepA, tstepB = 2 * hstepB;
    const unsigned ldsw = (unsigned)wid * 1024u;
    const int aoff = lds_byte(wr * 64 + fr, fq * 8), boff = lds_byte(wc * 32 + fr, fq * 8);
#define PG8_SA(b, h) (((b) * 2 + (h)) * HTB)
#define PG8_SB(b, h) ((4 + (b) * 2 + (h)) * HTB)
#define PG8_STAGE(bufoff, gbase, voff) do { _Pragma("unroll") for (int _i = 0; _i < 2; ++_i) \
        __builtin_amdgcn_global_load_lds((const GAS unsigned*)((const GAS char*)(gbase) + (voff)[_i]), (LAS unsigned*)(lds + (bufoff) + ldsw + _i * 8192), 16, 0, 0); } while (0)
#define PG8_LDA(dst, b, h) do { _Pragma("unroll") for (int m = 0; m < 4; ++m) _Pragma("unroll") for (int k = 0; k < 2; ++k) dst[m][k] = *(const LAS bf16x8*)(lds + PG8_SA(b, h) + aoff + m * 2048 + k * 1024); } while (0)
#define PG8_LDB(dst, b, h) do { _Pragma("unroll") for (int n = 0; n < 2; ++n) _Pragma("unroll") for (int k = 0; k < 2; ++k) dst[n][k] = *(const LAS bf16x8*)(lds + PG8_SB(b, h) + boff + n * 2048 + k * 1024); } while (0)
#define PG8_MMA(ai, bj, At, Bt) do { __builtin_amdgcn_s_setprio(1); _Pragma("unroll") for (int m = 0; m < 4; ++m) _Pragma("unroll") for (int n = 0; n < 2; ++n) _Pragma("unroll") for (int k = 0; k < 2; ++k) \
        acc[ai][bj][m][n] = __builtin_amdgcn_mfma_f32_16x16x32_bf16(Bt[n][k], At[m][k], acc[ai][bj][m][n], 0, 0, 0); __builtin_amdgcn_s_setprio(0); } while (0)
#define PG8_WAIT_V(n) asm volatile("s_waitcnt vmcnt(" #n ")" ::: "memory")
#define PG8_WAIT_L(n) asm volatile("s_waitcnt lgkmcnt(" #n ")" ::: "memory")
#define PG8_BAR __builtin_amdgcn_s_barrier()
#define PG8_SCHED __builtin_amdgcn_sched_barrier(0)
    Unit cur, nxt; int ui = 0;
    if (!S.next(0, cur)) return;
    f32x4 acc[2][2][4][2];
#pragma unroll
    for (int a = 0; a < 2; ++a)
#pragma unroll
        for (int b = 0; b < 2; ++b)
#pragma unroll
            for (int m = 0; m < 4; ++m)
#pragma unroll
                for (int n = 0; n < 2; ++n) acc[a][b][m][n] = (f32x4){0.f, 0.f, 0.f, 0.f};
    bf16x8 At[4][2], B0[2][2], B1[2][2];
    const GAS char* cA = (const GAS char*)g.A + (size_t)cur.pm * tstepA; const GAS char* cB = (const GAS char*)g.Bt + (size_t)cur.pn * tstepB;
    PG8_STAGE(PG8_SB(0, 0), cB, voffB); PG8_STAGE(PG8_SB(0, 1), cB + hstepB, voffB); PG8_STAGE(PG8_SA(0, 0), cA, voffA); PG8_STAGE(PG8_SA(0, 1), cA + hstepA, voffA);
    if (wr == 1) PG8_BAR;
    PG8_WAIT_V(2); PG8_BAR;
    PG8_STAGE(PG8_SB(1, 0), cB + kstep, voffB); PG8_STAGE(PG8_SA(1, 0), cA + kstep, voffA); PG8_STAGE(PG8_SB(1, 1), cB + hstepB + kstep, voffB);
    PG8_WAIT_V(6); PG8_BAR;
    for (;;) {
        const bool has_next = S.next(ui + 1, nxt);
        const GAS char* nA = has_next ? (const GAS char*)g.A + (size_t)nxt.pm * tstepA : cA; const GAS char* nB = has_next ? (const GAS char*)g.Bt + (size_t)nxt.pn * tstepB : cB;
#pragma unroll 8
        for (int t = 0; t < nt; t += 2) {
            const bool last = (t == nt - 2);
            const GAS char* a1 = cA + (size_t)(t + 1) * kstep;
            const GAS char* a2 = last ? nA : cA + (size_t)(t + 2) * kstep; const GAS char* b2 = last ? nB : cB + (size_t)(t + 2) * kstep;
            const GAS char* a3 = a2 + kstep; const GAS char* b3 = b2 + kstep;
            PG8_LDB(B0, 0, 0); PG8_LDB(B1, 0, 1); PG8_SCHED; PG8_LDA(At, 0, 0); PG8_STAGE(PG8_SA(1, 1), a1 + hstepA, voffA);
            PG8_WAIT_V(8); PG8_WAIT_L(0); PG8_BAR; PG8_MMA(0, 0, At, B0); PG8_MMA(0, 1, At, B1); PG8_BAR; PG8_SCHED;
            PG8_LDA(At, 0, 1); PG8_STAGE(PG8_SB(0, 0), b2, voffB); PG8_STAGE(PG8_SB(0, 1), b2 + hstepB, voffB); PG8_STAGE(PG8_SA(0, 0), a2, voffA);
            PG8_WAIT_V(8); PG8_WAIT_L(0); PG8_BAR; PG8_MMA(1, 0, At, B0); PG8_MMA(1, 1, At, B1); PG8_BAR; PG8_SCHED;
            PG8_LDB(B0, 1, 0); PG8_LDB(B1, 1, 1); PG8_SCHED; PG8_LDA(At, 1, 0); PG8_STAGE(PG8_SA(0, 1), a2 + hstepA, voffA);
            PG8_WAIT_V(8); PG8_WAIT_L(0); PG8_BAR; PG8_MMA(0, 0, At, B0); PG8_MMA(0, 1, At, B1); PG8_BAR; PG8_SCHED;
            PG8_LDA(At, 1, 1); PG8_STAGE(PG8_SB(1, 0), b3, voffB); PG8_STAGE(PG8_SB(1, 1), b3 + hstepB, voffB); PG8_STAGE(PG8_SA(1, 0), a3, voffA);
            PG8_WAIT_V(8); PG8_WAIT_L(0); PG8_BAR; PG8_MMA(1, 0, At, B0); PG8_MMA(1, 1, At, B1); PG8_BAR; PG8_SCHED;
        }
        if (wr == 0) PG8_BAR;
        { int l2_; asm volatile("v_mbcnt_lo_u32_b32 %0, -1, 0\n\tv_mbcnt_hi_u32_b32 %0, -1, %0" : "=v"(l2_));
          E(acc, cur, wr, wc, l2_ & 15, l2_ >> 4); }
        if (!has_next) break;
#pragma unroll
        for (int a = 0; a < 2; ++a)
#pragma unroll
            for (int b = 0; b < 2; ++b)
#pragma unroll
                for (int m = 0; m < 4; ++m)
#pragma unroll
                    for (int n = 0; n < 2; ++n) acc[a][b][m][n] = (f32x4){0.f, 0.f, 0.f, 0.f};
        cur = nxt; cA = nA; cB = nB; ++ui;
        if (wr == 1) PG8_BAR;
    }
    PG8_WAIT_V(0);
    PG8_BAR;
#undef PG8_SA
#undef PG8_SB
#undef PG8_STAGE
#undef PG8_LDA
#undef PG8_LDB
#undef PG8_MMA
#undef PG8_WAIT_V
#undef PG8_WAIT_L
#undef PG8_BAR
#undef PG8_SCHED
}
}


#define XB_TMO      128
#define XB_XCNT(j)  (256  + 64 * (j))
#define XB_XSUB(j)  (1280 + 64 * (j))
#define XB_XGEN(j)  (2304 + 64 * (j))
#define XB_TOP      3328
#define XB_TOPGEN   3392
#define XCD_BAR_WORDS 3456
#define XB_SPIN_CAP (1u << 18)
__device__ __forceinline__ unsigned xb_ld(unsigned* p)              { return __hip_atomic_load(p, __ATOMIC_RELAXED, __HIP_MEMORY_SCOPE_AGENT); }
__device__ __forceinline__ unsigned xb_add(unsigned* p, unsigned v) { return __hip_atomic_fetch_add(p, v, __ATOMIC_RELAXED, __HIP_MEMORY_SCOPE_AGENT); }
__device__ __forceinline__ unsigned xb_xcc_id() { return (unsigned)__builtin_amdgcn_s_getreg((3 << 11) | 20) & 0xFu; }
#define XB_SPIN(cond, bar) do { unsigned _sp = 0; while (cond) { __builtin_amdgcn_s_sleep(1); \
    if ((++_sp & 255u) == 0u) { if (xb_ld(&(bar)[XB_TMO])) break; if (_sp > XB_SPIN_CAP) { atomicAdd(&(bar)[XB_TMO], 1u); break; } } } } while (0)
struct XcdBarrier { unsigned* bar; unsigned x; volatile LAS unsigned* st; };
__device__ __forceinline__ XcdBarrier xcd_barrier_post(unsigned* bar, volatile LAS unsigned* st) {
    XcdBarrier b; b.bar = bar; b.x = xb_xcc_id(); b.st = st;
    if (threadIdx.x == 0) (void)xb_add(&bar[XB_XCNT(b.x)], 1u);
    return b;
}
__device__ __forceinline__ void xcd_barrier_complete(unsigned* bar, unsigned x, unsigned& nloc, unsigned& nx) {
    const unsigned G = gridDim.x * gridDim.y * gridDim.z;
    unsigned sum, cnt, mine, sp = 0u;
    for (;;) {
        sum = 0u; cnt = 0u; mine = 0u;
#pragma unroll
        for (unsigned j = 0; j < 16; ++j) { const unsigned c = xb_ld(&bar[XB_XCNT(j)]); sum += c; cnt += (c > 0u) ? 1u : 0u; mine = (j == x) ? c : mine; }
        if (sum == G) break;
        __builtin_amdgcn_s_sleep(1);
        if ((++sp & 255u) == 0u) { if (xb_ld(&bar[XB_TMO])) break; if (sp > XB_SPIN_CAP) { atomicAdd(&bar[XB_TMO], 1u); break; } }
    }
    nloc = mine > 0u ? mine : 1u; nx = cnt > 0u ? cnt : 1u;
}
__device__ __forceinline__ void xcd_barrier(const XcdBarrier& b) {
    asm volatile("s_waitcnt vmcnt(0)" ::: "memory");
    __syncthreads();
    if (threadIdx.x == 0) {
        unsigned* bar = b.bar;
        __builtin_amdgcn_s_waitcnt(0);
        unsigned nloc = b.st[0], nx = b.st[1];
        if (nloc == 0u) { xcd_barrier_complete(bar, b.x, nloc, nx); b.st[0] = nloc; b.st[1] = nx; }
        const unsigned old = xb_add(&bar[XB_XSUB(b.x)], 1u);
        const unsigned gen = old / nloc;
        if (old + 1u == (gen + 1u) * nloc) {
            __builtin_amdgcn_fence(__ATOMIC_RELEASE, "agent");
            asm volatile("s_waitcnt vmcnt(0)" ::: "memory");
            const unsigned og = xb_add(&bar[XB_TOP], 1u);
            const unsigned tg = og / nx;
            if (og + 1u == (tg + 1u) * nx) xb_add(&bar[XB_TOPGEN], 1u);
            else XB_SPIN(xb_ld(&bar[XB_TOPGEN]) == tg, bar);
            __builtin_amdgcn_fence(__ATOMIC_ACQUIRE, "agent");
            asm volatile("s_waitcnt vmcnt(0)" ::: "memory");
        } else {
            XB_SPIN(xb_ld(&bar[XB_TOPGEN]) == gen, bar);
            __builtin_amdgcn_fence(__ATOMIC_ACQUIRE, "agent");
            asm volatile("s_waitcnt vmcnt(0)" ::: "memory");
        }
    }
    __syncthreads();
}

__device__ __forceinline__ void conv_item(const float* W, int ldw, int K, int srccol0, GAS bf16_t* WT, int dstrow0, LAS float* scr, int kb, int lane, const float* gain) {
    const int k0 = 64 * kb; const GAS float* Wg = (const GAS float*)W; const GAS float* gg = (const GAS float*)gain;
    const int kr = lane >> 3, nq = lane & 7;
    f32x4 v[8];
#pragma unroll
    for (int i = 0; i < 8; ++i) v[i] = *(const GAS f32x4*)(Wg + (size_t)(k0 + 8 * i + kr) * ldw + srccol0 + 4 * nq);
    if (gain) {
#pragma unroll
        for (int i = 0; i < 8; ++i) v[i] = v[i] * gg[k0 + 8 * i + kr]; }
#pragma unroll
    for (int i = 0; i < 8; ++i) { LAS float* s = scr + (8 * i + kr) * 33 + 4 * nq; s[0] = v[i].x; s[1] = v[i].y; s[2] = v[i].z; s[3] = v[i].w; }
    LDS_WAIT(); asm volatile("" ::: "memory");
    const int c = lane & 7;
#pragma unroll
    for (int j = 0; j < 4; ++j) { const int n = (lane >> 3) + 8 * j; const LAS float* s = scr + (8 * c) * 33 + n;
        u32x4 o; o.x = pk2(s[0 * 33], s[1 * 33]); o.y = pk2(s[2 * 33], s[3 * 33]); o.z = pk2(s[4 * 33], s[5 * 33]); o.w = pk2(s[6 * 33], s[7 * 33]);
        *(GAS u32x4*)(WT + (size_t)(dstrow0 + n) * K + k0 + 8 * c) = o; }
    LDS_WAIT(); asm volatile("" ::: "memory");
}
__device__ __forceinline__ bool conv_job(int& r, const float* W, int ldw, int K, int c0, int type, int ncols, GAS bf16_t* WT, int row0, LAS float* scr, int lane, const float* gain) {
    const int nblk = ncols / 32, nitems = (K / 64) * nblk;
    if (r >= nitems) { r -= nitems; return false; }
    const int kb = r / nblk, n0 = 32 * (r % nblk);
    const int src = type == 0 ? c0 + n0 : c0 + (n0 >> 6) * 128 + (n0 & 63);
    conv_item(W, ldw, K, src, WT, row0 + n0, scr, kb, lane, gain);
    return true;
}
__device__ __forceinline__ void rms_row_bf16(const float* xrow, const float* g, GAS bf16_t* orow, int lane) {
    const GAS f32x4* xr = (const GAS f32x4*)xrow + lane; const GAS f32x4* gr = (const GAS f32x4*)g + lane;
    f32x4 v[4]; float s = 0.f;
#pragma unroll
    for (int j = 0; j < 4; ++j) { v[j] = xr[64 * j]; s += (v[j].x * v[j].x + v[j].y * v[j].y) + (v[j].z * v[j].z + v[j].w * v[j].w); }
    const float rs = 1.0f / sqrtf(wave_sum(s, lane) * (1.0f / 1024.0f) + EPS);
    GAS unsigned long long* o8 = (GAS unsigned long long*)orow + lane;
#pragma unroll
    for (int j = 0; j < 4; ++j) { const f32x4 gv = gr[64 * j]; const f32x4 y = v[j] * rs * gv;
        o8[64 * j] = (unsigned long long)pk2(y.x, y.y) | ((unsigned long long)pk2(y.z, y.w) << 32); }
}
__device__ __forceinline__ void copy_row_bf16_ssq(const float* xrow, GAS bf16_t* orow, GAS float* ssq16, int lane) {
    const GAS f32x4* xr = (const GAS f32x4*)xrow + lane;
    float s = 0.f;
    GAS unsigned long long* o8 = (GAS unsigned long long*)orow + lane;
#pragma unroll
    for (int j = 0; j < 4; ++j) { const f32x4 v = xr[64 * j]; const unsigned a = pk2(v.x, v.y), b = pk2(v.z, v.w);
        o8[64 * j] = (unsigned long long)a | ((unsigned long long)b << 32);
        const float r0 = bf2f(a & 0xffffu), r1 = bf2f(a >> 16), r2 = bf2f(b & 0xffffu), r3 = bf2f(b >> 16); s += (r0 * r0 + r1 * r1) + (r2 * r2 + r3 * r3); }
    s = wave_sum(s, lane);
    if (lane < 16) ssq16[lane] = lane == 0 ? s : 0.f;
}
__device__ __forceinline__ void rms_row_out(const GAS bf16_t* xrow, const float* g, float* orow, int lane) {
    const GAS u32x4* xr = (const GAS u32x4*)xrow + lane; const GAS f32x4* gr = (const GAS f32x4*)g; GAS f32x4* o = (GAS f32x4*)orow;
    float v[2][8]; float s = 0.f;
#pragma unroll
    for (int j = 0; j < 2; ++j) { const u32x4 w = xr[64 * j];
#pragma unroll
        for (int e = 0; e < 4; ++e) { v[j][2 * e] = bf2f(w[e] & 0xffffu); v[j][2 * e + 1] = bf2f(w[e] >> 16); s += v[j][2 * e] * v[j][2 * e] + v[j][2 * e + 1] * v[j][2 * e + 1]; } }
    const float rs = 1.0f / sqrtf(wave_sum(s, lane) * (1.0f / 1024.0f) + EPS);
#pragma unroll
    for (int j = 0; j < 2; ++j) { const int i4 = 128 * j + 2 * lane; const f32x4 g0 = gr[i4], g1 = gr[i4 + 1];
        o[i4] = (f32x4){v[j][0] * rs * g0.x, v[j][1] * rs * g0.y, v[j][2] * rs * g0.z, v[j][3] * rs * g0.w};
        o[i4 + 1] = (f32x4){v[j][4] * rs * g1.x, v[j][5] * rs * g1.y, v[j][6] * rs * g1.z, v[j][7] * rs * g1.w}; }
}
__device__ __forceinline__ void sincos_acc(float ang, float& sn, float& cs) {
    const double a = (double)ang; const double kd = __builtin_rint(a * 0.6366197723675814); const int k = (int)kd;
    const double r = (a - kd * 1.5707963267948966) - kd * 6.123233995736766e-17, r2 = r * r;
    const double sp = r * (1.0 + r2 * (-1.0 / 6 + r2 * (1.0 / 120 + r2 * (-1.0 / 5040 + r2 * (1.0 / 362880 + r2 * (-1.0 / 39916800))))));
    const double cp = 1.0 + r2 * (-0.5 + r2 * (1.0 / 24 + r2 * (-1.0 / 720 + r2 * (1.0 / 40320 + r2 * (-1.0 / 3628800 + r2 * (1.0 / 479001600))))));
    const int q = k & 3;
    const double s_ = (q == 0) ? sp : (q == 1) ? cp : (q == 2) ? -sp : -cp;
    const double c_ = (q == 0) ? cp : (q == 1) ? -sp : (q == 2) ? -cp : sp;
    sn = (float)s_; cs = (float)c_;
}

namespace att {
constexpr int KROW = 208, VROW = 144, KT_BYTES = 64 * KROW, VT_BYTES = 64 * VROW, BUF_BYTES = KT_BYTES + VT_BYTES;
struct Stage { u32x4 k1, k2, v; };
#define ATT_RD(F, BASE, OFF) asm volatile("ds_read_b128 %0, %1 offset:" #OFF : "=v"(F) : "v"(BASE))
#define ATT_WT(N, F) asm volatile("s_waitcnt lgkmcnt(" #N ")" : "+v"(F))
__device__ __forceinline__ void att_mseg_sp(unsigned kb, unsigned vb, const bf16x8 (&qf)[6], const f32x16& negm, f32x16& s0, f32x16& s1, const u32x4& w0, const u32x4& w1, const u32x4& w2, const u32x4& w3, f32x16& o0, f32x16& o1) {
    bf16x8 f0, f1, f2, f3, f4, f5;
    const bf16x8 p0 = __builtin_bit_cast(bf16x8, w0), p1 = __builtin_bit_cast(bf16x8, w1), p2 = __builtin_bit_cast(bf16x8, w2), p3 = __builtin_bit_cast(bf16x8, w3);
    ATT_RD(f0, kb, 0); ATT_RD(f1, kb, 6656); ATT_RD(f2, vb, 0); ATT_RD(f3, vb, 4608); ATT_RD(f4, kb, 32);
    ATT_WT(4, f0); s0 = __builtin_amdgcn_mfma_f32_32x32x16_bf16(f0, qf[0], negm, 0, 0, 0); ATT_RD(f5, kb, 6688);
    ATT_WT(4, f1); s1 = __builtin_amdgcn_mfma_f32_32x32x16_bf16(f1, qf[0], negm, 0, 0, 0); ATT_RD(f0, vb, 32);
    ATT_WT(4, f2); o0 = __builtin_amdgcn_mfma_f32_32x32x16_bf16(f2, p0, o0, 0, 0, 0); ATT_RD(f1, vb, 4640);
    ATT_WT(4, f3); o1 = __builtin_amdgcn_mfma_f32_32x32x16_bf16(f3, p0, o1, 0, 0, 0); ATT_RD(f2, kb, 64);
    ATT_WT(4, f4); s0 = __builtin_amdgcn_mfma_f32_32x32x16_bf16(f4, qf[1], s0, 0, 0, 0); ATT_RD(f3, kb, 6720);
    ATT_WT(4, f5); s1 = __builtin_amdgcn_mfma_f32_32x32x16_bf16(f5, qf[1], s1, 0, 0, 0); ATT_RD(f4, vb, 64);
    ATT_WT(4, f0); o0 = __builtin_amdgcn_mfma_f32_32x32x16_bf16(f0, p1, o0, 0, 0, 0); ATT_RD(f5, vb, 4672);
    ATT_WT(4, f1); o1 = __builtin_amdgcn_mfma_f32_32x32x16_bf16(f1, p1, o1, 0, 0, 0); ATT_RD(f0, kb, 96);
    ATT_WT(4, f2); s0 = __builtin_amdgcn_mfma_f32_32x32x16_bf16(f2, qf[2], s0, 0, 0, 0); ATT_RD(f1, kb, 6752);
    ATT_WT(4, f3); s1 = __builtin_amdgcn_mfma_f32_32x32x16_bf16(f3, qf[2], s1, 0, 0, 0); ATT_RD(f2, vb, 96);
    ATT_WT(4, f4); o0 = __builtin_amdgcn_mfma_f32_32x32x16_bf16(f4, p2, o0, 0, 0, 0); ATT_RD(f3, vb, 4704);
    ATT_WT(4, f5); o1 = __builtin_amdgcn_mfma_f32_32x32x16_bf16(f5, p2, o1, 0, 0, 0); ATT_RD(f4, kb, 128);
    ATT_WT(4, f0); s0 = __builtin_amdgcn_mfma_f32_32x32x16_bf16(f0, qf[3], s0, 0, 0, 0); ATT_RD(f5, kb, 6784);
    ATT_WT(4, f1); s1 = __builtin_amdgcn_mfma_f32_32x32x16_bf16(f1, qf[3], s1, 0, 0, 0); ATT_RD(f0, kb, 160);
    ATT_WT(4, f2); o0 = __builtin_amdgcn_mfma_f32_32x32x16_bf16(f2, p3, o0, 0, 0, 0); ATT_RD(f1, kb, 6816);
    ATT_WT(4, f3); o1 = __builtin_amdgcn_mfma_f32_32x32x16_bf16(f3, p3, o1, 0, 0, 0);
    ATT_WT(3, f4); s0 = __builtin_amdgcn_mfma_f32_32x32x16_bf16(f4, qf[4], s0, 0, 0, 0);
    ATT_WT(2, f5); s1 = __builtin_amdgcn_mfma_f32_32x32x16_bf16(f5, qf[4], s1, 0, 0, 0);
    ATT_WT(1, f0); s0 = __builtin_amdgcn_mfma_f32_32x32x16_bf16(f0, qf[5], s0, 0, 0, 0);
    ATT_WT(0, f1); s1 = __builtin_amdgcn_mfma_f32_32x32x16_bf16(f1, qf[5], s1, 0, 0, 0);
}
__device__ __forceinline__ void att_mseg_s(unsigned kb, const bf16x8 (&qf)[6], const f32x16& negm, f32x16& s0, f32x16& s1) {
    bf16x8 f0, f1, f2, f3, f4, f5;
    ATT_RD(f0, kb, 0); ATT_RD(f1, kb, 6656); ATT_RD(f2, kb, 32); ATT_RD(f3, kb, 6688); ATT_RD(f4, kb, 64);
    ATT_WT(4, f0); s0 = __builtin_amdgcn_mfma_f32_32x32x16_bf16(f0, qf[0], negm, 0, 0, 0); ATT_RD(f5, kb, 6720);
    ATT_WT(4, f1); s1 = __builtin_amdgcn_mfma_f32_32x32x16_bf16(f1, qf[0], negm, 0, 0, 0); ATT_RD(f0, kb, 96);
    ATT_WT(4, f2); s0 = __builtin_amdgcn_mfma_f32_32x32x16_bf16(f2, qf[1], s0, 0, 0, 0); ATT_RD(f1, kb, 6752);
    ATT_WT(4, f3); s1 = __builtin_amdgcn_mfma_f32_32x32x16_bf16(f3, qf[1], s1, 0, 0, 0); ATT_RD(f2, kb, 128);
    ATT_WT(4, f4); s0 = __builtin_amdgcn_mfma_f32_32x32x16_bf16(f4, qf[2], s0, 0, 0, 0); ATT_RD(f3, kb, 6784);
    ATT_WT(4, f5); s1 = __builtin_amdgcn_mfma_f32_32x32x16_bf16(f5, qf[2], s1, 0, 0, 0); ATT_RD(f4, kb, 160);
    ATT_WT(4, f0); s0 = __builtin_amdgcn_mfma_f32_32x32x16_bf16(f0, qf[3], s0, 0, 0, 0); ATT_RD(f5, kb, 6816);
    ATT_WT(4, f1); s1 = __builtin_amdgcn_mfma_f32_32x32x16_bf16(f1, qf[3], s1, 0, 0, 0);
    ATT_WT(3, f2); s0 = __builtin_amdgcn_mfma_f32_32x32x16_bf16(f2, qf[4], s0, 0, 0, 0);
    ATT_WT(2, f3); s1 = __builtin_amdgcn_mfma_f32_32x32x16_bf16(f3, qf[4], s1, 0, 0, 0);
    ATT_WT(1, f4); s0 = __builtin_amdgcn_mfma_f32_32x32x16_bf16(f4, qf[5], s0, 0, 0, 0);
    ATT_WT(0, f5); s1 = __builtin_amdgcn_mfma_f32_32x32x16_bf16(f5, qf[5], s1, 0, 0, 0);
}
__device__ __forceinline__ void att_mseg_sp(unsigned kb, unsigned vb, const bf16x8 (&qf)[4], const f32x16& negm, f32x16& s0, f32x16& s1, const u32x4& w0, const u32x4& w1, const u32x4& w2, const u32x4& w3, f32x16& o0, f32x16& o1) {
    bf16x8 f0, f1, f2, f3, f4, f5;
    const bf16x8 p0 = __builtin_bit_cast(bf16x8, w0), p1 = __builtin_bit_cast(bf16x8, w1), p2 = __builtin_bit_cast(bf16x8, w2), p3 = __builtin_bit_cast(bf16x8, w3);
    ATT_RD(f0, kb, 0); ATT_RD(f1, kb, 6656); ATT_RD(f2, vb, 0); ATT_RD(f3, vb, 4608); ATT_RD(f4, kb, 32);
    ATT_WT(4, f0); s0 = __builtin_amdgcn_mfma_f32_32x32x16_bf16(f0, qf[0], negm, 0, 0, 0); ATT_RD(f5, kb, 6688);
    ATT_WT(4, f1); s1 = __builtin_amdgcn_mfma_f32_32x32x16_bf16(f1, qf[0], negm, 0, 0, 0); ATT_RD(f0, vb, 32);
    ATT_WT(4, f2); o0 = __builtin_amdgcn_mfma_f32_32x32x16_bf16(f2, p0, o0, 0, 0, 0); ATT_RD(f1, vb, 4640);
    ATT_WT(4, f3); o1 = __builtin_amdgcn_mfma_f32_32x32x16_bf16(f3, p0, o1, 0, 0, 0); ATT_RD(f2, kb, 64);
    ATT_WT(4, f4); s0 = __builtin_amdgcn_mfma_f32_32x32x16_bf16(f4, qf[1], s0, 0, 0, 0); ATT_RD(f3, kb, 6720);
    ATT_WT(4, f5); s1 = __builtin_amdgcn_mfma_f32_32x32x16_bf16(f5, qf[1], s1, 0, 0, 0); ATT_RD(f4, vb, 64);
    ATT_WT(4, f0); o0 = __builtin_amdgcn_mfma_f32_32x32x16_bf16(f0, p1, o0, 0, 0, 0); ATT_RD(f5, vb, 4672);
    ATT_WT(4, f1); o1 = __builtin_amdgcn_mfma_f32_32x32x16_bf16(f1, p1, o1, 0, 0, 0); ATT_RD(f0, kb, 96);
    ATT_WT(4, f2); s0 = __builtin_amdgcn_mfma_f32_32x32x16_bf16(f2, qf[2], s0, 0, 0, 0); ATT_RD(f1, kb, 6752);
    ATT_WT(4, f3); s1 = __builtin_amdgcn_mfma_f32_32x32x16_bf16(f3, qf[2], s1, 0, 0, 0); ATT_RD(f2, vb, 96);
    ATT_WT(4, f4); o0 = __builtin_amdgcn_mfma_f32_32x32x16_bf16(f4, p2, o0, 0, 0, 0); ATT_RD(f3, vb, 4704);
    ATT_WT(4, f5); o1 = __builtin_amdgcn_mfma_f32_32x32x16_bf16(f5, p2, o1, 0, 0, 0);
    ATT_WT(3, f0); s0 = __builtin_amdgcn_mfma_f32_32x32x16_bf16(f0, qf[3], s0, 0, 0, 0);
    ATT_WT(2, f1); s1 = __builtin_amdgcn_mfma_f32_32x32x16_bf16(f1, qf[3], s1, 0, 0, 0);
    ATT_WT(1, f2); o0 = __builtin_amdgcn_mfma_f32_32x32x16_bf16(f2, p3, o0, 0, 0, 0);
    ATT_WT(0, f3); o1 = __builtin_amdgcn_mfma_f32_32x32x16_bf16(f3, p3, o1, 0, 0, 0);
}
__device__ __forceinline__ void att_mseg_s(unsigned kb, const bf16x8 (&qf)[4], const f32x16& negm, f32x16& s0, f32x16& s1) {
    bf16x8 f0, f1, f2, f3, f4, f5;
    ATT_RD(f0, kb, 0); ATT_RD(f1, kb, 6656); ATT_RD(f2, kb, 32); ATT_RD(f3, kb, 6688); ATT_RD(f4, kb, 64);
    ATT_WT(4, f0); s0 = __builtin_amdgcn_mfma_f32_32x32x16_bf16(f0, qf[0], negm, 0, 0, 0); ATT_RD(f5, kb, 6720);
    ATT_WT(4, f1); s1 = __builtin_amdgcn_mfma_f32_32x32x16_bf16(f1, qf[0], negm, 0, 0, 0); ATT_RD(f0, kb, 96);
    ATT_WT(4, f2); s0 = __builtin_amdgcn_mfma_f32_32x32x16_bf16(f2, qf[1], s0, 0, 0, 0); ATT_RD(f1, kb, 6752);
    ATT_WT(4, f3); s1 = __builtin_amdgcn_mfma_f32_32x32x16_bf16(f3, qf[1], s1, 0, 0, 0);
    ATT_WT(3, f4); s0 = __builtin_amdgcn_mfma_f32_32x32x16_bf16(f4, qf[2], s0, 0, 0, 0);
    ATT_WT(2, f5); s1 = __builtin_amdgcn_mfma_f32_32x32x16_bf16(f5, qf[2], s1, 0, 0, 0);
    ATT_WT(1, f0); s0 = __builtin_amdgcn_mfma_f32_32x32x16_bf16(f0, qf[3], s0, 0, 0, 0);
    ATT_WT(0, f1); s1 = __builtin_amdgcn_mfma_f32_32x32x16_bf16(f1, qf[3], s1, 0, 0, 0);
}
__device__ __forceinline__ void att_mseg_p(unsigned vb, const u32x4& w0, const u32x4& w1, const u32x4& w2, const u32x4& w3, f32x16& o0, f32x16& o1) {
    bf16x8 f0, f1, f2, f3, f4, f5;
    const bf16x8 p0 = __builtin_bit_cast(bf16x8, w0), p1 = __builtin_bit_cast(bf16x8, w1), p2 = __builtin_bit_cast(bf16x8, w2), p3 = __builtin_bit_cast(bf16x8, w3);
    ATT_RD(f0, vb, 0); ATT_RD(f1, vb, 4608); ATT_RD(f2, vb, 32); ATT_RD(f3, vb, 4640); ATT_RD(f4, vb, 64);
    ATT_WT(4, f0); o0 = __builtin_amdgcn_mfma_f32_32x32x16_bf16(f0, p0, o0, 0, 0, 0); ATT_RD(f5, vb, 4672);
    ATT_WT(4, f1); o1 = __builtin_amdgcn_mfma_f32_32x32x16_bf16(f1, p0, o1, 0, 0, 0); ATT_RD(f0, vb, 96);
    ATT_WT(4, f2); o0 = __builtin_amdgcn_mfma_f32_32x32x16_bf16(f2, p1, o0, 0, 0, 0); ATT_RD(f1, vb, 4704);
    ATT_WT(4, f3); o1 = __builtin_amdgcn_mfma_f32_32x32x16_bf16(f3, p1, o1, 0, 0, 0);
    ATT_WT(3, f4); o0 = __builtin_amdgcn_mfma_f32_32x32x16_bf16(f4, p2, o0, 0, 0, 0);
    ATT_WT(2, f5); o1 = __builtin_amdgcn_mfma_f32_32x32x16_bf16(f5, p2, o1, 0, 0, 0);
    ATT_WT(1, f0); o0 = __builtin_amdgcn_mfma_f32_32x32x16_bf16(f0, p3, o0, 0, 0, 0);
    ATT_WT(0, f1); o1 = __builtin_amdgcn_mfma_f32_32x32x16_bf16(f1, p3, o1, 0, 0, 0);
}
#undef ATT_RD
#undef ATT_WT
template <int MODE>
__device__ __forceinline__ void att_softmax(int t, bool first, f32x16& s0, f32x16& s1, f32x16& o0, f32x16& o1, float& lsum, f32x16& negm, u32x4& w0, u32x4& w1, u32x4& w2, u32x4& w3,
                                            int qw) {
    const int key0 = t * 64;
    if (MODE == 0 && key0 + 63 > qw) {
        const int l_ = lane_id_opaque(), qi = qw + (l_ & 31), hh = l_ >> 5;
#pragma unroll
        for (int i = 0; i < 16; ++i) { const int key = key0 + (i & 3) + 8 * (i >> 2) + 4 * hh; if (key > qi) s0[i] = -INFINITY; if (key + 32 > qi) s1[i] = -INFINITY; }
    }
    float a = fmaxf(fmaxf(s0[0], s0[1]), s1[0]), b = fmaxf(fmaxf(s0[2], s0[3]), s1[1]);
    a = fmaxf(fmaxf(a, s1[2]), s1[3]);
#pragma unroll
    for (int i = 4; i < 16; i += 4) { a = fmaxf(fmaxf(a, s0[i]), s0[i + 1]); b = fmaxf(fmaxf(b, s0[i + 2]), s0[i + 3]); a = fmaxf(fmaxf(a, s1[i]), s1[i + 1]); b = fmaxf(fmaxf(b, s1[i + 2]), s1[i + 3]); }
    float smax = fmaxf(a, b);
    { const auto rr = __builtin_amdgcn_permlane32_swap(__builtin_bit_cast(unsigned, smax), __builtin_bit_cast(unsigned, smax), false, false);
      smax = fmaxf(__builtin_bit_cast(float, (unsigned)rr[0]), __builtin_bit_cast(float, (unsigned)rr[1])); }
    if (first || (__builtin_amdgcn_ballot_w64(smax > RESCALE_THR) != 0ull)) {
        const float d = first ? smax : fmaxf(smax, 0.f);
#pragma unroll
        for (int i = 0; i < 16; ++i) { s0[i] -= d; s1[i] -= d; negm[i] -= d; }
        if (!first) { const float alpha = __builtin_amdgcn_exp2f(-d);
#pragma unroll
            for (int i = 0; i < 16; ++i) { o0[i] *= alpha; o1[i] *= alpha; } lsum *= alpha; }
    }
#pragma unroll
    for (int i = 0; i < 16; ++i) { s0[i] = __builtin_amdgcn_exp2f(s0[i]); s1[i] = __builtin_amdgcn_exp2f(s1[i]); }
    __builtin_amdgcn_sched_barrier(0);
    w0[0] = cvtpk(s0[0], s0[1]); w0[1] = cvtpk(s0[2], s0[3]); w0[2] = cvtpk(s0[4], s0[5]); w0[3] = cvtpk(s0[6], s0[7]);
    w1[0] = cvtpk(s0[8], s0[9]); w1[1] = cvtpk(s0[10], s0[11]); w1[2] = cvtpk(s0[12], s0[13]); w1[3] = cvtpk(s0[14], s0[15]);
    w2[0] = cvtpk(s1[0], s1[1]); w2[1] = cvtpk(s1[2], s1[3]); w2[2] = cvtpk(s1[4], s1[5]); w2[3] = cvtpk(s1[6], s1[7]);
    w3[0] = cvtpk(s1[8], s1[9]); w3[1] = cvtpk(s1[10], s1[11]); w3[2] = cvtpk(s1[12], s1[13]); w3[3] = cvtpk(s1[14], s1[15]);
    float ls_a = fadd_s(s0[0], s0[1]), ls_b = fadd_s(s0[2], s0[3]), ls_c = fadd_s(s1[0], s1[1]), ls_d = fadd_s(s1[2], s1[3]);
#pragma unroll
    for (int i = 4; i < 16; i += 4) { ls_a = fadd_s(ls_a, fadd_s(s0[i], s0[i + 1])); ls_b = fadd_s(ls_b, fadd_s(s0[i + 2], s0[i + 3])); ls_c = fadd_s(ls_c, fadd_s(s1[i], s1[i + 1])); ls_d = fadd_s(ls_d, fadd_s(s1[i + 2], s1[i + 3])); }
    ls_a = fadd_s(ls_a, ls_c); ls_b = fadd_s(ls_b, ls_d);
    lsum += ls_a + ls_b;
}
template <int DK, int MODE>
__device__ __forceinline__ void attn_unit(LAS unsigned char* lds, const GAS bf16_t* Qp, int ldq, const GAS bf16_t* K1, int ldk1, const GAS bf16_t* K2, int ldk2, const GAS bf16_t* Vt, int ldv,
                                          GAS bf16_t* O, int ldo, int q0, int t_lo, int t_hi, int tid) {
    const int wave = __builtin_amdgcn_readfirstlane(tid >> 6), lane = tid & 63, r = lane & 31, hh = lane >> 5;
    const int qw = q0 + 32 * wave, qi = qw + r;
    const bool late = wave >= 4;
    bf16x8 qf[DK / 16];
#pragma unroll
    for (int s = 0; s < DK / 16; ++s) qf[s] = *(const GAS bf16x8*)(Qp + (size_t)qi * ldq + 16 * s + 8 * hh);
    f32x16 o0, o1, negm, s0, s1; u32x4 w0, w1, w2, w3; float lsum = 0.f;
#pragma unroll
    for (int i = 0; i < 16; ++i) { o0[i] = 0.f; o1[i] = 0.f; negm[i] = 0.f; s0[i] = 0.f; s1[i] = 0.f; }
    w0 = (u32x4){0u, 0u, 0u, 0u}; w1 = w0; w2 = w0; w3 = w0;
    const int sk_row = tid >> 3, sk_ch = tid & 7;
    const unsigned vk1 = (unsigned)(sk_row * ldk1 + sk_ch * 8) * 2u, vk2 = (unsigned)(((tid >> 2) & 63) * ldk2 + (tid & 3) * 8) * 2u, vv = (unsigned)(sk_row * 64 + sk_ch * 8) * 2u;
    const size_t vts = (size_t)ldv * 64;
    const int kw_off = sk_row * KROW + sk_ch * 16, k2w_off = ((tid >> 2) & 63) * KROW + 128 + (tid & 3) * 16, vw_off = KT_BYTES + sk_row * VROW + (sk_ch >> 1) * 32 + (sk_ch & 1) * 8;
    const bool st_k2 = wave < 4;
    Stage A, B; A.k2 = (u32x4){0u, 0u, 0u, 0u}; B.k2 = A.k2;
#define ATT_LOAD1(R, tile) do { const int tl_ = (tile) < t_hi ? (tile) : t_hi - 1; const size_t k_ = (size_t)tl_ * 64; R.k1 = *(const GAS u32x4*)((const GAS char*)(K1 + k_ * ldk1) + vk1); \
        if (DK == 96) R.k2 = *(const GAS u32x4*)((const GAS char*)(K2 + k_ * ldk2) + vk2); R.v = *(const GAS u32x4*)((const GAS char*)(Vt + (size_t)tl_ * vts) + vv); } while (0)
#define ATT_STORE1(R, off) do { LAS unsigned char* b_ = lds + (off); *(LAS u32x4*)(b_ + kw_off) = R.k1; if (DK == 96) { if (st_k2) *(LAS u32x4*)(b_ + k2w_off) = R.k2; } \
        *(LAS u32x2*)(b_ + vw_off) = (u32x2){R.v.x, R.v.y}; *(LAS u32x2*)(b_ + vw_off + 16) = (u32x2){R.v.z, R.v.w}; } while (0)
#define ATT_NEED(t_) ((MODE == 2) || ((t_) * 64 <= qw + 31))
#define ATT_BUFO(t_) (((t_) & 3) * BUF_BYTES)
#define ATT_BAR  do { __builtin_amdgcn_sched_barrier(0); asm volatile("" ::: "memory"); __builtin_amdgcn_s_barrier(); asm volatile("" ::: "memory"); __builtin_amdgcn_sched_barrier(0); } while (0)
#define ATT_BARW do { __builtin_amdgcn_sched_barrier(0); asm volatile("s_waitcnt lgkmcnt(0)" ::: "memory"); __builtin_amdgcn_s_barrier(); asm volatile("" ::: "memory"); __builtin_amdgcn_sched_barrier(0); } while (0)
#define ATT_MSEG(u_) do { const unsigned kb_ = kfrag_a + ATT_BUFO(u_); const unsigned vb_ = vfrag_a + ATT_BUFO((u_) - 1); \
        if (ATT_NEED(u_)) att_mseg_sp(kb_, vb_, qf, negm, s0, s1, w0, w1, w2, w3, o0, o1); \
        else if (ATT_NEED((u_) - 1)) att_mseg_p(vb_, w0, w1, w2, w3, o0, o1); } while (0)
    const unsigned kfrag_a = (unsigned)(size_t)lds + (unsigned)(r * KROW + hh * 16), vfrag_a = (unsigned)(size_t)lds + (unsigned)(KT_BYTES + r * VROW + hh * 16);
    ATT_LOAD1(A, t_lo); ATT_LOAD1(B, t_lo + 1);
    ATT_STORE1(A, ATT_BUFO(t_lo)); ATT_STORE1(B, ATT_BUFO(t_lo + 1));
    ATT_LOAD1(A, t_lo + 2);
    ATT_BARW;
    if (late) ATT_BAR;
    if (ATT_NEED(t_lo)) att_mseg_s(kfrag_a + ATT_BUFO(t_lo), qf, negm, s0, s1);
    ATT_BAR;
    for (int t = t_lo; ; t += 2) {
        if (ATT_NEED(t)) att_softmax<MODE>(t, t == t_lo, s0, s1, o0, o1, lsum, negm, w0, w1, w2, w3, qw);
        __builtin_amdgcn_sched_barrier(0);
        if (t + 2 < t_hi) ATT_STORE1(A, ATT_BUFO(t + 2));
        ATT_LOAD1(A, t + 3);
        ATT_BARW;
        ATT_MSEG(t + 1);
        ATT_BAR;
        if (ATT_NEED(t + 1)) att_softmax<MODE>(t + 1, false, s0, s1, o0, o1, lsum, negm, w0, w1, w2, w3, qw);
        __builtin_amdgcn_sched_barrier(0);
        if (t + 3 < t_hi) ATT_STORE1(A, ATT_BUFO(t + 3));
        ATT_LOAD1(A, t + 4);
        ATT_BARW;
        if (t + 2 >= t_hi) break;
        ATT_MSEG(t + 2);
        ATT_BAR;
    }
    if (ATT_NEED(t_hi - 1)) att_mseg_p(vfrag_a + ATT_BUFO(t_hi - 1), w0, w1, w2, w3, o0, o1);
    if (!late) ATT_BAR;
#undef ATT_LOAD1
#undef ATT_STORE1
#undef ATT_NEED
#undef ATT_BUFO
#undef ATT_BAR
#undef ATT_BARW
#undef ATT_MSEG
    float inv;
    { const auto rr = __builtin_amdgcn_permlane32_swap(__builtin_bit_cast(unsigned, lsum), __builtin_bit_cast(unsigned, lsum), false, false);
      inv = 1.0f / (__builtin_bit_cast(float, (unsigned)rr[0]) + __builtin_bit_cast(float, (unsigned)rr[1])); }
    const int le_ = lane_id_opaque();
    GAS bf16_t* op = O + (size_t)(qw + (le_ & 31)) * ldo + 4 * (le_ >> 5);
#pragma unroll
    for (int g = 0; g < 4; ++g) {
        u32x2 w0_, w1_;
        w0_.x = cvtpk(o0[4 * g + 0] * inv, o0[4 * g + 1] * inv); w0_.y = cvtpk(o0[4 * g + 2] * inv, o0[4 * g + 3] * inv);
        w1_.x = cvtpk(o1[4 * g + 0] * inv, o1[4 * g + 1] * inv); w1_.y = cvtpk(o1[4 * g + 2] * inv, o1[4 * g + 3] * inv);
        *(GAS u32x2*)(op + 8 * g) = w0_; *(GAS u32x2*)(op + 32 + 8 * g) = w1_;
    }
}
constexpr int SW_ROW = 144, SW_KT = 64 * SW_ROW, SW_V_OFF = 6 * SW_KT, SW_P_OFF = 12 * SW_KT, SW_BYTES = SW_P_OFF + 6 * 256;
__device__ __forceinline__ void swa_unit(LAS unsigned char* lds, const GAS bf16_t* proj, const GAS bf16_t* Vt, GAS bf16_t* O, int kvh, int q0, const float* sinks, const GAS int* pos, int tid) {
    const int wave = __builtin_amdgcn_readfirstlane(tid >> 6), lane = tid & 63, r = lane & 31, hh = lane >> 5;
    const int qw = q0 + 32 * wave, qi = qw + r;
    const int tl = q0 >= 128 ? (q0 - 128) >> 6 : 0, th = (q0 + 256) >> 6, nt = th - tl;
    {
        const int sk_row = tid >> 3, sk_ch = tid & 7;
        const GAS bf16_t* gk = proj + (size_t)(tl * 64 + sk_row) * PROJ_LD + 768 + kvh * 64 + sk_ch * 8;
        const GAS bf16_t* gv = Vt + ((size_t)tl * 256 + sk_row) * 64 + sk_ch * 8;
        LAS unsigned char* kw = lds + sk_row * SW_ROW + sk_ch * 16; LAS unsigned char* vw = lds + SW_V_OFF + sk_row * SW_ROW + (sk_ch >> 1) * 32 + (sk_ch & 1) * 8;
#pragma unroll
        for (int bt = 0; bt < 2; ++bt) {
            u32x4 k0, k1, k2, v0, v1, v2; const int i0 = 3 * bt;
            k0 = *(const GAS u32x4*)(gk + (size_t)(i0 + 0) * 64 * PROJ_LD); v0 = *(const GAS u32x4*)(gv + (size_t)(i0 + 0) * 256 * 64);
            k1 = *(const GAS u32x4*)(gk + (size_t)(i0 + 1) * 64 * PROJ_LD); v1 = *(const GAS u32x4*)(gv + (size_t)(i0 + 1) * 256 * 64);
            const bool has2 = i0 + 2 < nt;
            k2 = k1; v2 = v1; if (has2) { k2 = *(const GAS u32x4*)(gk + (size_t)(i0 + 2) * 64 * PROJ_LD); v2 = *(const GAS u32x4*)(gv + (size_t)(i0 + 2) * 256 * 64); }
            if (i0 < nt) {
                *(LAS u32x4*)(kw + (i0 + 0) * SW_KT) = k0; *(LAS u32x2*)(vw + (i0 + 0) * SW_KT) = (u32x2){v0.x, v0.y}; *(LAS u32x2*)(vw + (i0 + 0) * SW_KT + 16) = (u32x2){v0.z, v0.w};
                if (i0 + 1 < nt) { *(LAS u32x4*)(kw + (i0 + 1) * SW_KT) = k1; *(LAS u32x2*)(vw + (i0 + 1) * SW_KT) = (u32x2){v1.x, v1.y}; *(LAS u32x2*)(vw + (i0 + 1) * SW_KT + 16) = (u32x2){v1.z, v1.w}; }
                if (has2) { *(LAS u32x4*)(kw + (i0 + 2) * SW_KT) = k2; *(LAS u32x2*)(vw + (i0 + 2) * SW_KT) = (u32x2){v2.x, v2.y}; *(LAS u32x2*)(vw + (i0 + 2) * SW_KT + 16) = (u32x2){v2.z, v2.w}; }
            }
        }
        if (tid < 64 * nt) *(LAS float*)(lds + SW_P_OFF + 4 * tid) = (float)pos[tl * 64 + tid];
    }
    __syncthreads();
    const float posq = (float)pos[qi];
    int ta = qw >= 127 ? ((qw - 127) >> 6) : 0; if (ta < tl) ta = tl; const int tb = (qw + 31) >> 6;
    const int koff = r * SW_ROW + hh * 16;
    for (int g = 0; g < 3; ++g) {
        const int h = kvh * 3 + g;
        const float slope = __builtin_amdgcn_exp2f(-(float)(h + 1) * (8.0f / 12.0f)) * LOG2E, sinkl = sinks[h] * LOG2E;
        bf16x8 q0f, q1f, q2f, q3f;
        { const GAS bf16_t* qp = proj + (size_t)qi * PROJ_LD + h * 64 + 8 * hh; q0f = *(const GAS bf16x8*)qp; q1f = *(const GAS bf16x8*)(qp + 16); q2f = *(const GAS bf16x8*)(qp + 32); q3f = *(const GAS bf16x8*)(qp + 48); }
        const float crow = slope * posq;
        float m = -1e30f, l = 0.f; f32x16 o0, o1;
#pragma unroll
        for (int i = 0; i < 16; ++i) { o0[i] = 0.f; o1[i] = 0.f; }
        for (int t = ta; t <= tb; ++t) {
            const LAS unsigned char* kb = lds + (t - tl) * SW_KT + koff; const LAS unsigned char* vb = kb + SW_V_OFF; const LAS float* pk = (const LAS float*)(lds + SW_P_OFF + (t - tl) * 256);
            f32x16 s0, s1;
#pragma unroll
            for (int i = 0; i < 16; ++i) { s0[i] = 0.f; s1[i] = 0.f; }
            s0 = __builtin_amdgcn_mfma_f32_32x32x16_bf16(*(const LAS bf16x8*)(kb), q0f, s0, 0, 0, 0); s1 = __builtin_amdgcn_mfma_f32_32x32x16_bf16(*(const LAS bf16x8*)(kb + 32 * SW_ROW), q0f, s1, 0, 0, 0);
            s0 = __builtin_amdgcn_mfma_f32_32x32x16_bf16(*(const LAS bf16x8*)(kb + 32), q1f, s0, 0, 0, 0); s1 = __builtin_amdgcn_mfma_f32_32x32x16_bf16(*(const LAS bf16x8*)(kb + 32 * SW_ROW + 32), q1f, s1, 0, 0, 0);
            s0 = __builtin_amdgcn_mfma_f32_32x32x16_bf16(*(const LAS bf16x8*)(kb + 64), q2f, s0, 0, 0, 0); s1 = __builtin_amdgcn_mfma_f32_32x32x16_bf16(*(const LAS bf16x8*)(kb + 32 * SW_ROW + 64), q2f, s1, 0, 0, 0);
            s0 = __builtin_amdgcn_mfma_f32_32x32x16_bf16(*(const LAS bf16x8*)(kb + 96), q3f, s0, 0, 0, 0); s1 = __builtin_amdgcn_mfma_f32_32x32x16_bf16(*(const LAS bf16x8*)(kb + 32 * SW_ROW + 96), q3f, s1, 0, 0, 0);
            const int key0 = t * 64; float smax = -INFINITY;
#pragma unroll
            for (int i = 0; i < 16; ++i) {
                const int kk = (i & 3) + 8 * (i >> 2) + 4 * hh; const int d0 = qi - (key0 + kk), d1 = d0 - 32;
                float v0 = __builtin_fmaf(slope, pk[kk], s0[i]), v1 = __builtin_fmaf(slope, pk[kk + 32], s1[i]);
                if (d0 < 0 || d0 >= 128) v0 = -INFINITY;
                if (d1 < 0 || d1 >= 128) v1 = -INFINITY;
                s0[i] = v0; s1[i] = v1; smax = fmaxf(smax, fmaxf(v0, v1));
            }
            { const auto rr = __builtin_amdgcn_permlane32_swap(__builtin_bit_cast(unsigned, smax), __builtin_bit_cast(unsigned, smax), false, false);
              smax = fmaxf(__builtin_bit_cast(float, (unsigned)rr[0]), __builtin_bit_cast(float, (unsigned)rr[1])); }
            if (__builtin_amdgcn_ballot_w64(smax - m > RESCALE_THR) != 0ull) {
                const float mn = fmaxf(m, smax), alpha = __builtin_amdgcn_exp2f(m - mn); m = mn; l *= alpha;
#pragma unroll
                for (int i = 0; i < 16; ++i) { o0[i] *= alpha; o1[i] *= alpha; }
            }
            float ls = 0.f; u32x4 w0, w1, w2, w3;
#define SW_P4(S, B, W, D) do { const float p0 = __builtin_amdgcn_exp2f(S[B] - m), p1 = __builtin_amdgcn_exp2f(S[B + 1] - m), p2 = __builtin_amdgcn_exp2f(S[B + 2] - m), p3 = __builtin_amdgcn_exp2f(S[B + 3] - m); \
                ls += p0; ls += p1; ls += p2; ls += p3; W[D] = cvtpk(p0, p1); W[D + 1] = cvtpk(p2, p3); } while (0)
            SW_P4(s0, 0, w0, 0); SW_P4(s0, 4, w0, 2); SW_P4(s0, 8, w1, 0); SW_P4(s0, 12, w1, 2);
            SW_P4(s1, 0, w2, 0); SW_P4(s1, 4, w2, 2); SW_P4(s1, 8, w3, 0); SW_P4(s1, 12, w3, 2);
#undef SW_P4
            l += ls;
            o0 = __builtin_amdgcn_mfma_f32_32x32x16_bf16(*(const LAS bf16x8*)(vb), __builtin_bit_cast(bf16x8, w0), o0, 0, 0, 0); o1 = __builtin_amdgcn_mfma_f32_32x32x16_bf16(*(const LAS bf16x8*)(vb + 32 * SW_ROW), __builtin_bit_cast(bf16x8, w0), o1, 0, 0, 0);
            o0 = __builtin_amdgcn_mfma_f32_32x32x16_bf16(*(const LAS bf16x8*)(vb + 32), __builtin_bit_cast(bf16x8, w1), o0, 0, 0, 0); o1 = __builtin_amdgcn_mfma_f32_32x32x16_bf16(*(const LAS bf16x8*)(vb + 32 * SW_ROW + 32), __builtin_bit_cast(bf16x8, w1), o1, 0, 0, 0);
            o0 = __builtin_amdgcn_mfma_f32_32x32x16_bf16(*(const LAS bf16x8*)(vb + 64), __builtin_bit_cast(bf16x8, w2), o0, 0, 0, 0); o1 = __builtin_amdgcn_mfma_f32_32x32x16_bf16(*(const LAS bf16x8*)(vb + 32 * SW_ROW + 64), __builtin_bit_cast(bf16x8, w2), o1, 0, 0, 0);
            o0 = __builtin_amdgcn_mfma_f32_32x32x16_bf16(*(const LAS bf16x8*)(vb + 96), __builtin_bit_cast(bf16x8, w3), o0, 0, 0, 0); o1 = __builtin_amdgcn_mfma_f32_32x32x16_bf16(*(const LAS bf16x8*)(vb + 32 * SW_ROW + 96), __builtin_bit_cast(bf16x8, w3), o1, 0, 0, 0);
        }
        { const auto rr = __builtin_amdgcn_permlane32_swap(__builtin_bit_cast(unsigned, l), __builtin_bit_cast(unsigned, l), false, false);
          l = __builtin_bit_cast(float, (unsigned)rr[0]) + __builtin_bit_cast(float, (unsigned)rr[1]); }
        l += __builtin_amdgcn_exp2f(sinkl + crow - m);
        const float inv = 1.0f / l;
        GAS bf16_t* op = O + (size_t)qi * 1024 + h * 64 + 4 * hh;
#pragma unroll
        for (int gg = 0; gg < 4; ++gg) {
            u32x2 a, b2;
            a.x = cvtpk(o0[4 * gg + 0] * inv, o0[4 * gg + 1] * inv); a.y = cvtpk(o0[4 * gg + 2] * inv, o0[4 * gg + 3] * inv);
            b2.x = cvtpk(o1[4 * gg + 0] * inv, o1[4 * gg + 1] * inv); b2.y = cvtpk(o1[4 * gg + 2] * inv, o1[4 * gg + 3] * inv);
            *(GAS u32x2*)(op + 8 * gg) = a; *(GAS u32x2*)(op + 32 + 8 * gg) = b2;
        }
    }
    __syncthreads();
}
}

__device__ __forceinline__ int opaque_zero() { int z; asm volatile("v_mov_b32 %0, 0" : "=v"(z)); return __builtin_amdgcn_readfirstlane(z); }
typedef const char __attribute__((address_space(4)))* kargp_t;
__device__ __forceinline__ unsigned long long opaque_u64(unsigned long long v) {
    const int lo_s = (int)(unsigned)v, hi_s = (int)(unsigned)(v >> 32); int lo, hi;
    asm volatile("v_mov_b32 %0, %2\n\tv_mov_b32 %1, %3" : "=&v"(lo), "=&v"(hi) : "s"(lo_s), "s"(hi_s));
    return ((unsigned long long)(unsigned)__builtin_amdgcn_readfirstlane(hi) << 32) | (unsigned long long)(unsigned)__builtin_amdgcn_readfirstlane(lo);
}
__device__ __forceinline__ const void* ld_arg(kargp_t kp, int byte_off) {
    return *(const void* const __attribute__((address_space(4)))*)(kp + byte_off);
}
#define INP(i) ((const float*)ld_arg(kp, 8 * (i)))
#define GB(off) ((GAS bf16_t*)(ws + (off)))
#define GF(off) ((GAS float*)(ws + (off)))
#define x_in INP(0)
#define mem INP(1)
#define positions ((const int*)ld_arg(kp, 16))
#define attn_norm_g INP(3)
#define mlp_norm_g INP(4)
#define mem_norm_g INP(5)
#define final_norm_g INP(6)
#define mla_w_in INP(7)
#define mla_q_norm_g INP(8)
#define mla_kv_norm_g INP(9)
#define mla_w_uq INP(10)
#define mla_w_ukv INP(11)
#define swa_w_in INP(12)
#define swa_sinks INP(13)
#define w_mem_kv INP(14)
#define w_o INP(15)
#define mlp_w_up INP(16)
#define mlp_w_down INP(17)
#define xres ((float*)ld_arg(kp, 144))

__device__ __forceinline__ int conv_layer_total(int L) { return ((L & 1) == 0 ? (16 * 29 + 6 * 36 + 4 * 24 + 4 * 24) : (16 * 32 + 16 * 8 + 16 * 8)) + 16 * 8 + 16 * 8 + 16 * 32 + 16 * 128 + 64 * 32; }
__device__ __forceinline__ void conv_layer_item(kargp_t kp, unsigned char* wsb, int L, int it, LAS float* scr, int lane) {
    const int j = L >> 1; int r = it;
    const float* ga = attn_norm_g + L * D;
    if ((L & 1) == 0) {
        if (conv_job(r, mla_w_in + (size_t)j * 1024 * 928, 928, 1024, 0, 0, 928, (GAS bf16_t*)(wsb + WO_IN), 0, scr, lane, ga)) return;
        if (conv_job(r, mla_w_uq + (size_t)j * 384 * 1152, 1152, 384, 0, 0, 1152, (GAS bf16_t*)(wsb + WO_UQ), 0, scr, lane, mla_q_norm_g + j * 384)) return;
        if (conv_job(r, mla_w_ukv + (size_t)j * 256 * 1536, 1536, 256, 0, 1, 768, (GAS bf16_t*)(wsb + WO_UK), 0, scr, lane, mla_kv_norm_g + j * 256)) return;
        if (conv_job(r, mla_w_ukv + (size_t)j * 256 * 1536, 1536, 256, 64, 1, 768, (GAS bf16_t*)(wsb + WO_UV), 0, scr, lane, mla_kv_norm_g + j * 256)) return;
    } else {
        if (conv_job(r, swa_w_in + (size_t)j * 1024 * 1536, 1536, 1024, 0, 0, 1024, (GAS bf16_t*)(wsb + WO_IN), 0, scr, lane, ga)) return;
        if (conv_job(r, swa_w_in + (size_t)j * 1024 * 1536, 1536, 1024, 1280, 0, 256, (GAS bf16_t*)(wsb + WO_IN), 1024, scr, lane, ga)) return;
        if (conv_job(r, swa_w_in + (size_t)j * 1024 * 1536, 1536, 1024, 1024, 0, 256, (GAS bf16_t*)(wsb + WO_V), 0, scr, lane, ga)) return;
    }
    if (conv_job(r, w_mem_kv + (size_t)L * 1024 * 512, 512, 1024, 0, 0, 256, (GAS bf16_t*)(wsb + WO_MK), 0, scr, lane, nullptr)) return;
    if (conv_job(r, w_mem_kv + (size_t)L * 1024 * 512, 512, 1024, 256, 0, 256, (GAS bf16_t*)(wsb + WO_MV), 0, scr, lane, nullptr)) return;
    if (conv_job(r, w_o + (size_t)L * 1024 * 1024, 1024, 1024, 0, 0, 1024, (GAS bf16_t*)(wsb + WO_O), 0, scr, lane, nullptr)) return;
    if (conv_job(r, mlp_w_up + (size_t)L * 1024 * 4096, 4096, 1024, 0, 0, 4096, (GAS bf16_t*)(wsb + WO_UP), 0, scr, lane, mlp_norm_g + L * D)) return;
    (void)conv_job(r, mlp_w_down + (size_t)L * 4096 * 1024, 1024, 4096, 0, 0, 1024, (GAS bf16_t*)(wsb + WO_DN), 0, scr, lane, nullptr);
}

struct Args { const void* in[18]; float* out; unsigned char* ws; int ph_lo, ph_hi; };
constexpr int N_PHASES = 24;

__global__ void __launch_bounds__(NWAVES * 64, 2) trunk_fwd(Args args) {
    extern __shared__ __attribute__((aligned(16))) unsigned char lds_raw[];
    LAS unsigned char* lds = (LAS unsigned char*)lds_raw;
    volatile LAS unsigned* MISC = (volatile LAS unsigned*)(lds + MISC_OFF);
    unsigned* ctl = (unsigned*)(args.ws + WS_CTL);
    const int wave0 = __builtin_amdgcn_readfirstlane(threadIdx.x >> 6);
    for (int u = threadIdx.x; u < (LDS_BYTES - LDSCTL_OFF) / 4; u += NWAVES * 64) ((LAS unsigned*)(lds + LDSCTL_OFF))[u] = 0u;
    __syncthreads();
    unsigned bar_x = 0; (void)bar_x;
#if !MK_PER_PHASE_LAUNCH
    { XcdBarrier b0_ = xcd_barrier_post(ctl + CW_BAR, MISC + 8); bar_x = b0_.x; }
#endif
    const int lo = args.ph_lo, hi = args.ph_hi;
    int ph = 0;

#define PHASE_BEGIN if (ph >= lo && ph < hi) { const int zz = opaque_zero(); unsigned char* ws = (unsigned char*)opaque_u64((unsigned long long)args.ws); \
        kargp_t kp = (kargp_t)opaque_u64((unsigned long long)__builtin_amdgcn_kernarg_segment_ptr()); (void)kp; \
        const int tid = wave0 * 64 + lane_id_opaque(); \
        const int G = (int)gridDim.x + zz, bx = (int)blockIdx.x + zz, vcu = (G % 8 == 0) ? (bx % 8) * (G / 8) + bx / 8 : bx, NGW = G * NWAVES; (void)NGW; const int lane = tid & 63, wave = __builtin_amdgcn_readfirstlane(tid >> 6); \
        const int gw = vcu * NWAVES + wave; LAS float* scr = (LAS float*)(lds + wave * 16384); (void)ws; (void)lane; (void)gw; (void)scr;
#if MK_PER_PHASE_LAUNCH
#define PHASE_END } ++ph;
#else
#define PHASE_END if (ph + 1 < hi) { XcdBarrier b_; b_.bar = (unsigned*)ws + CW_BAR; b_.x = bar_x + (unsigned)zz; b_.st = MISC + 8; xcd_barrier(b_); } } ++ph;
#endif
#define GEMM_RUN(EPI, ...) do { pg8::StaticOrder So; So.init(g.M, g.N, G, bx, rot); EPI E{__VA_ARGS__}; pg8::gemm_phase(lds, g, So, E, wave0); rot += (g.M / 256) * (g.N / 256); } while (0)

    PHASE_BEGIN
        for (int i = bx * (NWAVES * 64) + tid; i < T * 16; i += G * NWAVES * 64) {
            const int t = i >> 4, f = i & 15; const float ang = (float)positions[t] * rope_inv[f];
            float sn, cs; sincos_acc(ang, sn, cs); GF(WS_COS)[i] = cs; GF(WS_SIN)[i] = sn;
        }
        for (int rr = gw; rr < NB * NMEM; rr += NGW) rms_row_bf16(mem + (size_t)rr * D, mem_norm_g, GB(WS_MEMN) + (size_t)rr * D, lane);
        { const int total = conv_layer_total(0); for (int it = gw; it < total; it += NGW) conv_layer_item(kp, ws + WS_WSET, 0, it, scr, lane); }
        for (int rr = gw; rr < T; rr += NGW) copy_row_bf16_ssq(x_in + (size_t)rr * D, GB(WS_XB) + (size_t)rr * D, GF(WS_SSQ) + (size_t)rr * 16, lane);
    PHASE_END

    for (int L = 0; L < DEPTH; ++L) {
        const bool mla = (L & 1) == 0; const int j = L >> 1;
        PHASE_BEGIN
            unsigned char* wsb = ws + WS_WSET + (size_t)(L & 1) * WSET_BYTES; int rot = 0;
            if (mla) {
                pg8::Gemm g{GB(WS_XB), (GAS bf16_t*)(wsb + WO_IN), T, 1024, 1024, 1024, 1024};
                GEMM_RUN(pg8::EpiProjMla, GB(WS_PROJ), PROJ_LD, GF(WS_SSQ), GF(WS_SSQ32), GF(WS_COS), GF(WS_SIN));
            } else {
                { pg8::Gemm g{GB(WS_XB), (GAS bf16_t*)(wsb + WO_IN), T, 1280, 1024, 1024, 1024}; using E_ = pg8::EpiBf16<0, 1, 0, false, true>; GEMM_RUN(E_, GB(WS_PROJ), PROJ_LD, GF(WS_SSQ)); }
                { pg8::Gemm g{(GAS bf16_t*)(wsb + WO_V), GB(WS_XB), 256, T, 1024, 1024, 1024}; using E_ = pg8::EpiBf16<0, 2, 0, true>; GEMM_RUN(E_, GB(WS_VT), 256, GF(WS_SSQ)); }
                { pg8::Gemm g{GB(WS_MEMN), (GAS bf16_t*)(wsb + WO_MK), 1024, 256, 1024, 1024, 1024}; using E_ = pg8::EpiBf16<0, 0, 0>; GEMM_RUN(E_, GB(WS_MEMK), 256, nullptr); }
                { pg8::Gemm g{(GAS bf16_t*)(wsb + WO_MV), GB(WS_MEMN), 256, 1024, 1024, 1024, 1024}; using E_ = pg8::EpiBf16<0, 0, 0, true>; GEMM_RUN(E_, GB(WS_MEMVT), 256, nullptr); }
            }
        PHASE_END
        if (mla) {
            PHASE_BEGIN
                unsigned char* wsb = ws + WS_WSET + (size_t)(L & 1) * WSET_BYTES; int rot = 0;
                { pg8::Gemm g{GB(WS_PROJ), (GAS bf16_t*)(wsb + WO_UQ), T, 1280, 384, PROJ_LD, 384}; GEMM_RUN(pg8::EpiRope, GB(WS_Q), QLD, GF(WS_COS), GF(WS_SIN), GF(WS_SSQ32)); }
                { pg8::Gemm g{GB(WS_PROJ) + 384, (GAS bf16_t*)(wsb + WO_UK), T, 768, 256, PROJ_LD, 256}; using E_ = pg8::EpiBf16<0, 1, 2>; GEMM_RUN(E_, GB(WS_KN), 768, GF(WS_SSQ32)); }
                { pg8::Gemm g{(GAS bf16_t*)(wsb + WO_UV), GB(WS_PROJ) + 384, 768, T, 256, 256, PROJ_LD}; using E_ = pg8::EpiBf16<0, 2, 2, true>; GEMM_RUN(E_, GB(WS_VT), 768, GF(WS_SSQ32)); }
                { pg8::Gemm g{GB(WS_MEMN), (GAS bf16_t*)(wsb + WO_MK), 1024, 256, 1024, 1024, 1024}; using E_ = pg8::EpiBf16<0, 0, 0>; GEMM_RUN(E_, GB(WS_MEMK), 256, nullptr); }
                { pg8::Gemm g{(GAS bf16_t*)(wsb + WO_MV), GB(WS_MEMN), 256, 1024, 1024, 1024, 1024}; using E_ = pg8::EpiBf16<0, 0, 0, true>; GEMM_RUN(E_, GB(WS_MEMVT), 256, nullptr); }
            PHASE_END
        }
        PHASE_BEGIN
            {
            unsigned* qctr = (unsigned*)ws + CW_ATTQ + 64 * L;
            volatile LAS int* slot = (volatile LAS int*)(MISC + 16);
            const int conv_total = (L + 1 < DEPTH) ? conv_layer_total(L + 1) : 0;
            const int n_mix = mla ? 768 : 256, u_conv = n_mix + 256, n_units = u_conv + (conv_total + 31) / 32;
            const int NQ = (mla && (G % 8 == 0)) ? 8 : 1, n_loc = mla ? 768 / NQ : 0, myq = bx % NQ;
            unsigned* qloc = qctr + 1 + myq; int loc_live = n_loc;
#define ATT_FETCH(dst) do { int f_ = -1; if (loc_live) { const unsigned v_ = __hip_atomic_fetch_add(qloc, 1u, __ATOMIC_RELAXED, __HIP_MEMORY_SCOPE_AGENT); if ((int)v_ < n_loc) f_ = myq * n_loc + (int)v_; else loc_live = 0; } \
                if (f_ < 0) f_ = (mla ? 768 : 0) + (int)__hip_atomic_fetch_add(qctr, 1u, __ATOMIC_RELAXED, __HIP_MEMORY_SCOPE_AGENT); dst = f_; } while (0)
            if (tid == 0) { int f0_; ATT_FETCH(f0_); slot[0] = f0_; }
            __syncthreads();
            for (;;) {
                const int u = __builtin_amdgcn_readfirstlane(slot[0]);
                __syncthreads();
                if (u >= n_units) break;
                int nxt = 0; if (tid == 0) ATT_FETCH(nxt);
                int tid_u = tid; asm volatile("" : "+v"(tid_u));
                const GAS bf16_t* gPROJ = GB(WS_PROJ); GAS bf16_t* gATT = GB(WS_ATT); const GAS bf16_t* gVT = GB(WS_VT);
                if (u < n_mix) {
                    if (mla) {
                        const int qq = u / n_loc, qi_ = u % n_loc, per_q = 48 / NQ; const int qb = 15 - qi_ / per_q, bh = (qi_ % per_q) * NQ + qq, b = bh / 12, h = bh % 12; const int q0 = qb * 256; const size_t rb = (size_t)b * S;
                        att::attn_unit<96, 0>(lds, GB(WS_Q) + rb * QLD + h * 96, QLD, GB(WS_KN) + rb * 768 + h * 64, 768, gPROJ + rb * PROJ_LD + 640, PROJ_LD, gVT + ((size_t)(b * 64) * 768 + h * 64) * 64, 768,
                                              gATT + rb * 1024 + h * 64, 1024, q0, 0, (q0 + 256) / 64, tid_u);
                    } else {
                        const int qb = 15 - u / 16, bk = u % 16, b = bk / 4, kvh = bk % 4; const int q0 = qb * 256; const size_t rb = (size_t)b * S;
                        att::swa_unit(lds, gPROJ + rb * PROJ_LD, gVT + ((size_t)(b * 64) * 256 + kvh * 64) * 64, gATT + rb * 1024, kvh, q0, swa_sinks + j * 12, (const GAS int*)positions + rb, tid_u);
                    }
                } else if (u < u_conv) {
                    const int v = u - n_mix, qb = v / 16, bh = v % 16, b = bh / 4, hc = bh % 4; const int q0 = qb * 256; const size_t rb = (size_t)b * S;
                    const int qc_off = mla ? 672 : 1024;
                    att::attn_unit<64, 2>(lds, gPROJ + rb * PROJ_LD + qc_off + hc * 64, PROJ_LD, GB(WS_MEMK) + (size_t)(b * NMEM) * 256 + hc * 64, 256, nullptr, 0, GB(WS_MEMVT) + ((size_t)(b * 4) * 256 + hc * 64) * 64, 256,
                                          gATT + rb * 1024 + 768 + hc * 64, 1024, q0, zz, NMEM / 64 + zz, tid_u);
                } else {
                    unsigned char* wsn = (unsigned char*)opaque_u64((unsigned long long)(ws + WS_WSET + (size_t)((L + 1) & 1) * WSET_BYTES));
                    kargp_t kp_u = (kargp_t)opaque_u64((unsigned long long)kp);
                    const int lane_u = tid_u & 63, wave_u = __builtin_amdgcn_readfirstlane(tid_u >> 6); LAS float* scr_u = (LAS float*)(lds + wave_u * 16384);
                    for (int k = 0; k < 4; ++k) { const int it = (u - u_conv) * 32 + wave_u * 4 + k; if (it < conv_total) conv_layer_item(kp_u, wsn, L + 1, it, scr_u, lane_u); }
                }
                if (tid == 0) slot[0] = nxt;
                __syncthreads();
            }
#undef ATT_FETCH
            }
        PHASE_END
        PHASE_BEGIN
            unsigned char* wsb = ws + WS_WSET + (size_t)(L & 1) * WSET_BYTES; int rot = 0;
            { pg8::Gemm g{GB(WS_ATT), (GAS bf16_t*)(wsb + WO_O), T, 1024, 1024, 1024, 1024};
              GEMM_RUN(pg8::EpiResNorm<false>, GB(WS_XB), GF(WS_SSQA), nullptr, D); }
        PHASE_END
        PHASE_BEGIN
            unsigned char* wsb = ws + WS_WSET + (size_t)(L & 1) * WSET_BYTES; int rot = 0;
            { pg8::Gemm g{GB(WS_XB), (GAS bf16_t*)(wsb + WO_UP), T, FF, 1024, 1024, 1024}; using E_ = pg8::EpiBf16<1, 0, 0>; GEMM_RUN(E_, GB(WS_ABUF), FF, nullptr); }
        PHASE_END
        PHASE_BEGIN
            unsigned char* wsb = ws + WS_WSET + (size_t)(L & 1) * WSET_BYTES; int rot = 0;
            { pg8::Gemm g{GB(WS_ABUF), (GAS bf16_t*)(wsb + WO_DN), T, 1024, FF, FF, FF};
              GEMM_RUN(pg8::EpiResNorm<true>, GB(WS_XB), GF(WS_SSQ), GF(WS_SSQA), D); }
        PHASE_END
    }
    PHASE_BEGIN
        for (int rr = gw; rr < T; rr += NGW) rms_row_out(GB(WS_XB) + (size_t)rr * D, final_norm_g, xres + (size_t)rr * D, lane);
    PHASE_END
#undef PHASE_BEGIN
#undef PHASE_END
}

extern "C" void kernel_launch(void* const* d_in, const int* in_sizes, int n_in, void* d_out, int out_size, void* d_ws, size_t ws_size, hipStream_t stream) {
    static int grid = 0;
    if (grid == 0) {
        if (n_in != 18 || out_size != T * D || ws_size < WS_END) { fprintf(stderr, "kernel_launch: unexpected shapes (n_in %d out %d ws %zu)\n", n_in, out_size, ws_size); grid = -1; return; }
        int dev = 0, cus = 0, per_cu = 0;
        if (hipGetDevice(&dev) != hipSuccess || hipDeviceGetAttribute(&cus, hipDeviceAttributeMultiprocessorCount, dev) != hipSuccess) { grid = -1; return; }
        if (hipFuncSetAttribute((const void*)trunk_fwd, hipFuncAttributeMaxDynamicSharedMemorySize, LDS_BYTES) != hipSuccess) { fprintf(stderr, "kernel_launch: hipFuncSetAttribute failed\n"); grid = -1; return; }
        if (hipOccupancyMaxActiveBlocksPerMultiprocessor(&per_cu, (const void*)trunk_fwd, NWAVES * 64, LDS_BYTES) != hipSuccess || per_cu < 1)
            fprintf(stderr, "kernel_launch: occupancy query reports %d blocks per CU\n", per_cu);
        (void)hipGetLastError();
        grid = cus;
    }
    if (grid < 0) return;
    (void)hipMemsetAsync((char*)d_ws + WS_CTL, 0, CTL_ZERO_BYTES, stream);
    Args a{};
    for (int i = 0; i < 18; ++i) a.in[i] = d_in[i];
    a.out = (float*)d_out; a.ws = (unsigned char*)d_ws;
#if MK_PER_PHASE_LAUNCH
    for (int p = 0; p < N_PHASES; ++p) { a.ph_lo = p; a.ph_hi = p + 1; hipLaunchKernelGGL(trunk_fwd, dim3(grid), dim3(NWAVES * 64), LDS_BYTES, stream, a); }
#else
    a.ph_lo = 0; a.ph_hi = N_PHASES;
    hipLaunchKernelGGL(trunk_fwd, dim3(grid), dim3(NWAVES * 64), LDS_BYTES, stream, a);
#endif
}
```

```cpp
#include <hip/hip_runtime.h>
#include <cstdio>
#include <cstdint>

#ifndef MK_PER_PHASE_LAUNCH
#define MK_PER_PHASE_LAUNCH 0
#endif

#define LAS __attribute__((address_space(3)))
#define GAS __attribute__((address_space(1)))
typedef unsigned short bf16_t;
typedef short bf16x8 __attribute__((ext_vector_type(8)));
typedef short s16x4 __attribute__((ext_vector_type(4)));
typedef float f32x2 __attribute__((ext_vector_type(2)));
typedef float f32x4 __attribute__((ext_vector_type(4)));
typedef float f32x16 __attribute__((ext_vector_type(16)));
typedef unsigned u32x2 __attribute__((ext_vector_type(2)));
typedef unsigned u32x4 __attribute__((ext_vector_type(4)));
typedef __bf16 bf16x2_t __attribute__((ext_vector_type(2)));

constexpr int NB = 4, S = 4096, T = NB * S, D = 1024, FF = 4096, NMEM = 256, DEPTH = 4;
constexpr int PROJ_LD = 1280;
constexpr int QLD = 1280;
constexpr float EPS = 1e-6f;
constexpr float LOG2E = 1.4426950408889634f;
constexpr float QS_MLA = 0.10206207261596577f * LOG2E, QS_64 = 0.125f * LOG2E;
constexpr float RESCALE_THR = 8.0f;

constexpr size_t MiB = 1u << 20;
constexpr size_t WS_CTL = 0, CTL_ZERO_BYTES = 128 * 1024;
constexpr size_t WS_COS = 1 * MiB, WS_SIN = 2 * MiB;
constexpr size_t WS_MEMN = 3 * MiB;
constexpr size_t WS_MEMK = 5 * MiB, WS_MEMVT = 5 * MiB + 512 * 1024;
constexpr size_t WS_SSQ = 6 * MiB;
constexpr size_t WS_SSQA = 9 * MiB;
constexpr size_t WS_SSQ32 = 7 * MiB;
constexpr size_t WS_WSET = 10 * MiB, WSET_BYTES = 25 * MiB;
constexpr size_t WO_IN = 0;
constexpr size_t WO_UQ = 5 * MiB / 2;
constexpr size_t WO_UK = 7 * MiB / 2, WO_UV = 4 * MiB;
constexpr size_t WO_V = 9 * MiB / 2;
constexpr size_t WO_MK = 5 * MiB, WO_MV = 11 * MiB / 2;
constexpr size_t WO_O = 6 * MiB;
constexpr size_t WO_UP = 8 * MiB;
constexpr size_t WO_DN = 16 * MiB;
constexpr size_t WS_XB = 60 * MiB;
constexpr size_t WS_ABUF = 92 * MiB;
constexpr size_t WS_PROJ = 92 * MiB;
constexpr size_t WS_Q = 132 * MiB;
constexpr size_t WS_KN = 172 * MiB;
constexpr size_t WS_VT = 196 * MiB;
constexpr size_t WS_ATT = 220 * MiB;
constexpr size_t WS_END = 252 * MiB;
constexpr int CW_ATTQ = 16384;
constexpr int CW_BAR = 4096;

constexpr int RING_BYTES = 131072;
constexpr int LDSCTL_OFF = RING_BYTES, MISC_OFF = LDSCTL_OFF + 320;
constexpr int LDS_BYTES = 147456;
constexpr int NWAVES = 8;

__device__ const float rope_inv[16] = {1.0f, 0.5623413251903491f, 0.31622776601683794f, 0.1778279410038923f, 0.1f, 0.05623413251903491f,
    0.03162277660168379f, 0.01778279410038923f, 0.01f, 0.005623413251903491f, 0.0031622776601683794f, 0.0017782794100389228f, 0.001f,
    0.0005623413251903491f, 0.00031622776601683794f, 0.00017782794100389227f};

__device__ __forceinline__ unsigned f2bf(float f) { unsigned u = __builtin_bit_cast(unsigned, f); return (u + 0x7fffu + ((u >> 16) & 1u)) >> 16; }
__device__ __forceinline__ unsigned pk2(float lo, float hi) { return f2bf(lo) | (f2bf(hi) << 16); }
__device__ __forceinline__ float bf2f(unsigned b) { return __builtin_bit_cast(float, b << 16); }
__device__ __forceinline__ unsigned cvtpk(float lo, float hi) { f32x2 v = {lo, hi}; bf16x2_t b = __builtin_convertvector(v, bf16x2_t); return __builtin_bit_cast(unsigned, b); }
#define LDS_WAIT() asm volatile("s_waitcnt lgkmcnt(0)" ::: "memory")
#define VM_WAIT() asm volatile("s_waitcnt vmcnt(0)" ::: "memory")
__device__ __forceinline__ float shfl_xor_l(float v, int o, int lane) { return __builtin_bit_cast(float, __builtin_amdgcn_ds_bpermute((lane ^ o) << 2, __builtin_bit_cast(int, v))); }
__device__ __forceinline__ float wave_sum(float v, int lane) {
#pragma unroll
    for (int o = 1; o < 64; o <<= 1) v += shfl_xor_l(v, o, lane);
    return v;
}
__device__ __forceinline__ float fadd_s(float a, float b) { float r; asm("v_add_f32 %0, %1, %2" : "=v"(r) : "v"(a), "v"(b)); return r; }
__device__ __forceinline__ int lane_id_opaque() { int l; asm volatile("v_mbcnt_lo_u32_b32 %0, -1, 0\n\tv_mbcnt_hi_u32_b32 %0, -1, %0" : "=v"(l)); return l; }

template <int FN> __device__ __forceinline__ float row_rs(const GAS float* ssq, int row) {
    if (FN == 0) { const GAS f32x4* p = (const GAS f32x4*)(ssq + (size_t)row * 16); const f32x4 a = p[0], b = p[1], c = p[2], d = p[3];
        const float s = ((a.x + a.y) + (a.z + a.w)) + ((b.x + b.y) + (b.z + b.w)) + ((c.x + c.y) + (c.z + c.w)) + ((d.x + d.y) + (d.z + d.w)); return __builtin_amdgcn_rsqf(s * (1.0f / 1024.0f) + EPS); }
    if (FN == 1) { const GAS f32x4* p = (const GAS f32x4*)(ssq + (size_t)row * 32); const f32x4 a = p[0], b = p[1], c = p[2];
        const float s = ((a.x + a.y) + (a.z + a.w)) + ((b.x + b.y) + (b.z + b.w)) + ((c.x + c.y) + (c.z + c.w)); return __builtin_amdgcn_rsqf(s * (1.0f / 384.0f) + EPS); }
    const GAS f32x4* p = (const GAS f32x4*)(ssq + (size_t)row * 32 + 12); const f32x4 a = p[0], b = p[1];
    const float s = ((a.x + a.y) + (a.z + a.w)) + ((b.x + b.y) + (b.z + b.w)); return __builtin_amdgcn_rsqf(s * (1.0f / 256.0f) + EPS);
}

namespace pg8 {
constexpr int BM = 256, BK = 64, HALF = 128, HTB = HALF * BK * 2, STAGE_BYTES = 8 * HTB, NXCD = 8, WGM = 8;
__host__ __device__ __forceinline__ int lds_byte(int r, int c) { const int st = (r >> 4) * 2 + (c >> 5), rr = r & 15, cc = c & 31, ob = rr * 64 + cc * 2; return st * 1024 + (ob ^ (((ob >> 9) & 1) << 5)); }
__host__ __device__ __forceinline__ void stage_rc(int b, int& R, int& C) { const int st = b / 1024, sb = b % 1024, swz = sb ^ (((sb >> 9) & 1) << 5); R = (st >> 1) * 16 + swz / 64; C = (st & 1) * 32 + (swz % 64) / 2; }
__host__ __device__ __forceinline__ int perm32(int rho) { const int n = rho >> 4, i = rho & 15; return 8 * (i >> 2) + 4 * n + (i & 3); }

struct Unit { int pm, pn; };
struct Gemm { const GAS bf16_t* A; const GAS bf16_t* Bt; int M, N, K, lda, ldb; };

struct StaticOrder {
    int nM, nN, nwg, G, c;
    __device__ void init(int M, int N, int G_, int c_, int rot) { nM = M / BM; nN = N / BM; nwg = nM * nN; G = G_; c = (c_ + G_ - (rot % G_)) % G_; }
    __device__ bool next(int i, Unit& u) const {
        const long L = (long)i * G + c; if (L >= nwg) return false;
        int wgid = (int)L; { const int q = nwg / NXCD, r = nwg % NXCD, xcd = wgid % NXCD, off = wgid / NXCD; wgid = (xcd < r ? xcd * (q + 1) : r * (q + 1) + (xcd - r) * q) + off; }
        const int nig = WGM * nN, gid = wgid / nig, fm = gid * WGM, gsz = (nM - fm) < WGM ? (nM - fm) : WGM;
        u.pm = fm + ((wgid % nig) % gsz); u.pn = (wgid % nig) / gsz; return true;
    }
};

__device__ __forceinline__ unsigned cvt_pk_bf16(float lo, float hi) { unsigned r; asm volatile("v_cvt_pk_bf16_f32 %0, %1, %2" : "=v"(r) : "v"(lo), "v"(hi)); return r; }

template <int ACT  , int AXIS, int FN, bool VTL = false, bool QSC = false> struct EpiBf16 {
    static constexpr bool PERM = true;
    GAS bf16_t* O; int ldc; const GAS float* ssq;
    __device__ __forceinline__ void operator()(const f32x4 (&acc)[2][2][4][2], const Unit& u, int wr, int wc, int fr, int fq) const {
        const int row0 = u.pm * BM + wr * 64 + fr; const int col0 = u.pn * BM + wc * 32 + 8 * fq;
        float cs[2][8];
        if (AXIS == 2) {
#pragma unroll
            for (int bj = 0; bj < 2; ++bj)
#pragma unroll
                for (int k = 0; k < 8; ++k) cs[bj][k] = row_rs<FN>(ssq, col0 + bj * HALF + k);
        }
#pragma unroll
        for (int ai = 0; ai < 2; ++ai)
#pragma unroll
            for (int m = 0; m < 4; ++m) { const int row = row0 + ai * HALF + m * 16;
                GAS bf16_t* rowp = VTL ? O + ((size_t)(col0 >> 6) * ldc + row) * 64 + (col0 & 63) : O + (size_t)row * ldc + col0;
                float rs = 1.f; if (AXIS == 1) rs = row_rs<FN>(ssq, row);
#pragma unroll
                for (int bj = 0; bj < 2; ++bj) { f32x4 v0 = acc[ai][bj][m][0], v1 = acc[ai][bj][m][1];
                    if (AXIS == 1) { float rq = rs; if (QSC) { const int g32 = u.pn * 8 + bj * 4 + wc; rq = (g32 < 24 || g32 >= 32) ? rs * QS_64 : rs; } v0 = v0 * rq; v1 = v1 * rq; }
                    if (AXIS == 2) {
#pragma unroll
                        for (int e = 0; e < 4; ++e) { v0[e] *= cs[bj][e]; v1[e] *= cs[bj][4 + e]; } }
                    if (ACT == 1) {
#pragma unroll
                        for (int e = 0; e < 4; ++e) { const float a = fmaxf(v0[e], 0.f), b = fmaxf(v1[e], 0.f); v0[e] = a * a; v1[e] = b * b; } }
                    u32x4 w; w.x = cvt_pk_bf16(v0[0], v0[1]); w.y = cvt_pk_bf16(v0[2], v0[3]); w.z = cvt_pk_bf16(v1[0], v1[1]); w.w = cvt_pk_bf16(v1[2], v1[3]);
                    *(GAS u32x4*)(rowp + (VTL ? (size_t)bj * 2 * ldc * 64 : (size_t)bj * HALF)) = w; } }
    }
};
template <bool SCALED> struct EpiResNorm {
    static constexpr bool PERM = true;
    GAS bf16_t* xb; GAS float* ssq; const GAS float* ssq_in; int ldc;
    __device__ __forceinline__ void operator()(const f32x4 (&acc)[2][2][4][2], const Unit& u, int wr, int wc, int fr, int fq) const {
        const int row0 = u.pm * BM + wr * 64 + fr, col0 = u.pn * BM + wc * 32 + 8 * fq; const int lane = fq * 16 + fr;
#pragma unroll
        for (int ai = 0; ai < 2; ++ai)
#pragma unroll
            for (int m = 0; m < 4; ++m) { const int row = row0 + ai * HALF + m * 16; GAS bf16_t* rowp = xb + (size_t)row * ldc + col0; float part = 0.f;
                float r2 = 1.f;
                if (SCALED) { const GAS f32x4* p = (const GAS f32x4*)(ssq_in + (size_t)row * 16); const f32x4 a = p[0], b = p[1], c = p[2], d = p[3];
                    const float s = ((a.x + a.y) + (a.z + a.w)) + ((b.x + b.y) + (b.z + b.w)) + ((c.x + c.y) + (c.z + c.w)) + ((d.x + d.y) + (d.z + d.w)); r2 = __builtin_amdgcn_rcpf(s * (1.0f / 1024.0f) + EPS); }
#pragma unroll
                for (int bj = 0; bj < 2; ++bj) { const u32x4 old = *(const GAS u32x4*)(rowp + bj * HALF); f32x4 v0 = acc[ai][bj][m][0], v1 = acc[ai][bj][m][1];
                    if (SCALED) { v0 = v0 * r2; v1 = v1 * r2; }
                    const float x0 = bf2f(old.x & 0xffffu) + v0[0], x1 = bf2f(old.x >> 16) + v0[1], x2 = bf2f(old.y & 0xffffu) + v0[2], x3 = bf2f(old.y >> 16) + v0[3];
                    const float x4 = bf2f(old.z & 0xffffu) + v1[0], x5 = bf2f(old.z >> 16) + v1[1], x6 = bf2f(old.w & 0xffffu) + v1[2], x7 = bf2f(old.w >> 16) + v1[3];
                    u32x4 w; w.x = cvt_pk_bf16(x0, x1); w.y = cvt_pk_bf16(x2, x3); w.z = cvt_pk_bf16(x4, x5); w.w = cvt_pk_bf16(x6, x7);
                    *(GAS u32x4*)(rowp + bj * HALF) = w;
                    part += ((x0 * x0 + x1 * x1) + (x2 * x2 + x3 * x3)) + ((x4 * x4 + x5 * x5) + (x6 * x6 + x7 * x7)); }
                part += shfl_xor_l(part, 16, lane); part += shfl_xor_l(part, 32, lane);
                if (fq == 0) ssq[(size_t)row * 16 + u.pn * 4 + wc] = part; }
    }
};
struct EpiRope {
    static constexpr bool PERM = false;
    GAS bf16_t* O; int ldc; const GAS float* cs; const GAS float* sn; const GAS float* ssq32;
    __device__ __forceinline__ void operator()(const f32x4 (&acc)[2][2][4][2], const Unit& u, int wr, int wc, int fr, int fq) const {
        const int row0 = u.pm * BM + wr * 64 + fr;
#pragma unroll
        for (int ai = 0; ai < 2; ++ai)
#pragma unroll
            for (int m = 0; m < 4; ++m) { const int row = row0 + ai * HALF + m * 16; const float rs = row_rs<1>(ssq32, row) * QS_MLA;
                const f32x4 c = *(const GAS f32x4*)(cs + (size_t)row * 16 + 4 * fq), s = *(const GAS f32x4*)(sn + (size_t)row * 16 + 4 * fq);
#pragma unroll
                for (int bj = 0; bj < 2; ++bj) { const int cb = u.pn * BM + bj * HALF + wc * 32; const bool rope = ((cb >> 5) % 3) == 2;
                    f32x4 v0 = acc[ai][bj][m][0] * rs, v1 = acc[ai][bj][m][1] * rs;
                    if (rope) { const f32x4 a = v0 * c - v1 * s, b = v0 * s + v1 * c; v0 = a; v1 = b; }
                    u32x2 w0, w1; w0.x = cvt_pk_bf16(v0[0], v0[1]); w0.y = cvt_pk_bf16(v0[2], v0[3]); w1.x = cvt_pk_bf16(v1[0], v1[1]); w1.y = cvt_pk_bf16(v1[2], v1[3]);
                    GAS bf16_t* p = O + (size_t)row * ldc + cb + 4 * fq; *(GAS u32x2*)p = w0; *(GAS u32x2*)(p + 16) = w1; } }
    }
};
struct EpiProjMla {
    static constexpr bool PERM = false;
    GAS bf16_t* O; int ldc; const GAS float* ssq; GAS float* ssq32; const GAS float* cs; const GAS float* sn;
    __device__ __forceinline__ void operator()(const f32x4 (&acc)[2][2][4][2], const Unit& u, int wr, int wc, int fr, int fq) const {
        const int row0 = u.pm * BM + wr * 64 + fr; const int lane = fq * 16 + fr;
#pragma unroll
        for (int ai = 0; ai < 2; ++ai)
#pragma unroll
            for (int m = 0; m < 4; ++m) { const int row = row0 + ai * HALF + m * 16; const float rs = row_rs<0>(ssq, row);
#pragma unroll
                for (int bj = 0; bj < 2; ++bj) { const int g32 = u.pn * 8 + bj * 4 + wc; const int cb = g32 * 32;
                    f32x4 v0 = acc[ai][bj][m][0] * rs, v1 = acc[ai][bj][m][1] * rs;
                    if (g32 < 20) { float part = ((v0[0] * v0[0] + v0[1] * v0[1]) + (v0[2] * v0[2] + v0[3] * v0[3])) + ((v1[0] * v1[0] + v1[1] * v1[1]) + (v1[2] * v1[2] + v1[3] * v1[3]));
                        part += shfl_xor_l(part, 16, lane); part += shfl_xor_l(part, 32, lane);
                        if (fq == 0) ssq32[(size_t)row * 32 + g32] = part; }
                    if (g32 == 20) { const f32x4 c = *(const GAS f32x4*)(cs + (size_t)row * 16 + 4 * fq), s = *(const GAS f32x4*)(sn + (size_t)row * 16 + 4 * fq);
                        const f32x4 a = v0 * c - v1 * s, b = v0 * s + v1 * c; v0 = a; v1 = b; }
                    if (g32 > 20 && g32 < 29) { v0 = v0 * QS_64; v1 = v1 * QS_64; }
                    u32x2 w0, w1; w0.x = cvt_pk_bf16(v0[0], v0[1]); w0.y = cvt_pk_bf16(v0[2], v0[3]); w1.x = cvt_pk_bf16(v1[0], v1[1]); w1.y = cvt_pk_bf16(v1[2], v1[3]);
                    GAS bf16_t* p = O + (size_t)row * ldc + cb + 4 * fq; *(GAS u32x2*)p = w0; *(GAS u32x2*)(p + 16) = w1; } }
    }
};

template <class Epi>
__device__ __forceinline__ void gemm_phase(LAS unsigned char* lds, const Gemm g, const StaticOrder& S, const Epi& E, int wave_sgpr) {
    int tid; asm volatile("v_mbcnt_lo_u32_b32 %0, -1, 0\n\tv_mbcnt_hi_u32_b32 %0, -1, %0" : "=v"(tid)); tid += wave_sgpr * 64;
    const int wid = __builtin_amdgcn_readfirstlane(tid >> 6), lane = tid & 63, wr = wid >> 2, wc = wid & 3, fr = lane & 15, fq = lane >> 4;
    const int K = g.K, nt = K / BK;
    unsigned voffA[2], voffB[2];
#pragma unroll
    for (int i = 0; i < 2; ++i) { int R, C; stage_rc(tid * 16 + i * 8192, R, C); const int Rb = Epi::PERM ? ((R & ~31) + perm32(R & 31)) : R;
        voffA[i] = (unsigned)(R * g.lda + C) * 2u; voffB[i] = (unsigned)(Rb * g.ldb + C) * 2u; }
    const size_t kstep = (size_t)(BK * 2);
    const size_t hstepA = (size_t)HALF * g.lda * 2, hstepB = (size_t)HALF * g.ldb * 2;
    const size_t tstepA = 2 * hstepA, tstepB = 2 * hstepB;
    const unsigned ldsw = (unsigned)wid * 1024u;
    const int aoff = lds_byte(wr * 64 + fr, fq * 8), boff = lds_byte(wc * 32 + fr, fq * 8);
#define PG8_SA(b, h) (((b) * 2 + (h)) * HTB)
#define PG8_SB(b, h) ((4 + (b) * 2 + (h)) * HTB)
#define PG8_STAGE(bufoff, gbase, voff) do { _Pragma("unroll") for (int _i = 0; _i < 2; ++_i) \
        __builtin_amdgcn_global_load_lds((const GAS unsigned*)((const GAS char*)(gbase) + (voff)[_i]), (LAS unsigned*)(lds + (bufoff) + ldsw + _i * 8192), 16, 0, 0); } while (0)
#define PG8_LDA(dst, b, h) do { _Pragma("unroll") for (int m = 0; m < 4; ++m) _Pragma("unroll") for (int k = 0; k < 2; ++k) dst[m][k] = *(const LAS bf16x8*)(lds + PG8_SA(b, h) + aoff + m * 2048 + k * 1024); } while (0)
#define PG8_LDB(dst, b, h) do { _Pragma("unroll") for (int n = 0; n < 2; ++n) _Pragma("unroll") for (int k = 0; k < 2; ++k) dst[n][k] = *(const LAS bf16x8*)(lds + PG8_SB(b, h) + boff + n * 2048 + k * 1024); } while (0)
#define PG8_MMA(ai, bj, At, Bt) do { __builtin_amdgcn_s_setprio(1); _Pragma("unroll") for (int m = 0; m < 4; ++m) _Pragma("unroll") for (int n = 0; n < 2; ++n) _Pragma("unroll") for (int k = 0; k < 2; ++k) \
        acc[ai][bj][m][n] = __builtin_amdgcn_mfma_f32_16x16x32_bf16(Bt[n][k], At[m][k], acc[ai][bj][m][n], 0, 0, 0); __builtin_amdgcn_s_setprio(0); } while (0)
#define PG8_WAIT_V(n) asm volatile("s_waitcnt vmcnt(" #n ")" ::: "memory")
#define PG8_WAIT_L(n) asm volatile("s_waitcnt lgkmcnt(" #n ")" ::: "memory")
#define PG8_BAR __builtin_amdgcn_s_barrier()
#define PG8_SCHED __builtin_amdgcn_sched_barrier(0)
    Unit cur, nxt; int ui = 0;
    if (!S.next(0, cur)) return;
    f32x4 acc[2][2][4][2];
#pragma unroll
    for (int a = 0; a < 2; ++a)
#pragma unroll
        for (int b = 0; b < 2; ++b)
#pragma unroll
            for (int m = 0; m < 4; ++m)
#pragma unroll
                for (int n = 0; n < 2; ++n) acc[a][b][m][n] = (f32x4){0.f, 0.f, 0.f, 0.f};
    bf16x8 At[4][2], B0[2][2], B1[2][2];
    const GAS char* cA = (const GAS char*)g.A + (size_t)cur.pm * tstepA; const GAS char* cB = (const GAS char*)g.Bt + (size_t)cur.pn * tstepB;
    PG8_STAGE(PG8_SB(0, 0), cB, voffB); PG8_STAGE(PG8_SB(0, 1), cB + hstepB, voffB); PG8_STAGE(PG8_SA(0, 0), cA, voffA); PG8_STAGE(PG8_SA(0, 1), cA + hstepA, voffA);
    if (wr == 1) PG8_BAR;
    PG8_WAIT_V(2); PG8_BAR;
    PG8_STAGE(PG8_SB(1, 0), cB + kstep, voffB); PG8_STAGE(PG8_SA(1, 0), cA + kstep, voffA); PG8_STAGE(PG8_SB(1, 1), cB + hstepB + kstep, voffB);
    PG8_WAIT_V(6); PG8_BAR;
    for (;;) {
        const bool has_next = S.next(ui + 1, nxt);
        const GAS char* nA = has_next ? (const GAS char*)g.A + (size_t)nxt.pm * tstepA : cA; const GAS char* nB = has_next ? (const GAS char*)g.Bt + (size_t)nxt.pn * tstepB : cB;
#pragma unroll 8
        for (int t = 0; t < nt; t += 2) {
            const bool last = (t == nt - 2);
            const GAS char* a1 = cA + (size_t)(t + 1) * kstep;
            const GAS char* a2 = last ? nA : cA + (size_t)(t + 2) * kstep; const GAS char* b2 = last ? nB : cB + (size_t)(t + 2) * kstep;
            const GAS char* a3 = a2 + kstep; const GAS char* b3 = b2 + kstep;
            PG8_LDB(B0, 0, 0); PG8_LDB(B1, 0, 1); PG8_SCHED; PG8_LDA(At, 0, 0); PG8_STAGE(PG8_SA(1, 1), a1 + hstepA, voffA);
            PG8_WAIT_V(8); PG8_WAIT_L(0); PG8_BAR; PG8_MMA(0, 0, At, B0); PG8_MMA(0, 1, At, B1); PG8_BAR; PG8_SCHED;
            PG8_LDA(At, 0, 1); PG8_STAGE(PG8_SB(0, 0), b2, voffB); PG8_STAGE(PG8_SB(0, 1), b2 + hstepB, voffB); PG8_STAGE(PG8_SA(0, 0), a2, voffA);
            PG8_WAIT_V(8); PG8_WAIT_L(0); PG8_BAR; PG8_MMA(1, 0, At, B0); PG8_MMA(1, 1, At, B1); PG8_BAR; PG8_SCHED;
            PG8_LDB(B0, 1, 0); PG8_LDB(B1, 1, 1); PG8_SCHED; PG8_LDA(At, 1, 0); PG8_STAGE(PG8_SA(0, 1), a2 + hstepA, voffA);
            PG8_WAIT_V(8); PG8_WAIT_L(0); PG8_BAR; PG8_MMA(0, 0, At, B0); PG8_MMA(0, 1, At, B1); PG8_BAR; PG8_SCHED;
            PG8_LDA(At, 1, 1); PG8_STAGE(PG8_SB(1, 0), b3, voffB); PG8_STAGE(PG8_SB(1, 1), b3 + hstepB, voffB); PG8_STAGE(PG8_SA(1, 0), a3, voffA);
            PG8_WAIT_V(8); PG8_WAIT_L(0); PG8_BAR; PG8_MMA(1, 0, At, B0); PG8_MMA(1, 1, At, B1); PG8_BAR; PG8_SCHED;
        }
        if (wr == 0) PG8_BAR;
        { int l2_; asm volatile("v_mbcnt_lo_u32_b32 %0, -1, 0\n\tv_mbcnt_hi_u32_b32 %0, -1, %0" : "=v"(l2_));
          E(acc, cur, wr, wc, l2_ & 15, l2_ >> 4); }
        if (!has_next) break;
#pragma unroll
        for (int a = 0; a < 2; ++a)
#pragma unroll
            for (int b = 0; b < 2; ++b)
#pragma unroll
                for (int m = 0; m < 4; ++m)
#pragma unroll
                    for (int n = 0; n < 2; ++n) acc[a][b][m][n] = (f32x4){0.f, 0.f, 0.f, 0.f};
        cur = nxt; cA = nA; cB = nB; ++ui;
        if (wr == 1) PG8_BAR;
    }
    PG8_WAIT_V(0);
    PG8_BAR;
#undef PG8_SA
#undef PG8_SB
#undef PG8_STAGE
#undef PG8_LDA
#undef PG8_LDB
#undef PG8_MMA
#undef PG8_WAIT_V
#undef PG8_WAIT_L
#undef PG8_BAR
#undef PG8_SCHED
}
}


#define XB_TMO      128
#define XB_XCNT(j)  (256  + 64 * (j))
#define XB_XSUB(j)  (1280 + 64 * (j))
#define XB_XGEN(j)  (2304 + 64 * (j))
#define XB_TOP      3328
#define XB_TOPGEN   3392
#define XCD_BAR_WORDS 3456
#define XB_SPIN_CAP (1u << 18)
__device__ __forceinline__ unsigned xb_ld(unsigned* p)              { return __hip_atomic_load(p, __ATOMIC_RELAXED, __HIP_MEMORY_SCOPE_AGENT); }
__device__ __forceinline__ unsigned xb_add(unsigned* p, unsigned v) { return __hip_atomic_fetch_add(p, v, __ATOMIC_RELAXED, __HIP_MEMORY_SCOPE_AGENT); }
__device__ __forceinline__ unsigned xb_xcc_id() { return (unsigned)__builtin_amdgcn_s_getreg((3 << 11) | 20) & 0xFu; }
#define XB_SPIN(cond, bar) do { unsigned _sp = 0; while (cond) { __builtin_amdgcn_s_sleep(1); \
    if ((++_sp & 255u) == 0u) { if (xb_ld(&(bar)[XB_TMO])) break; if (_sp > XB_SPIN_CAP) { atomicAdd(&(bar)[XB_TMO], 1u); break; } } } } while (0)
struct XcdBarrier { unsigned* bar; unsigned x; volatile LAS unsigned* st; };
__device__ __forceinline__ XcdBarrier xcd_barrier_post(unsigned* bar, volatile LAS unsigned* st) {
    XcdBarrier b; b.bar = bar; b.x = xb_xcc_id(); b.st = st;
    if (threadIdx.x == 0) (void)xb_add(&bar[XB_XCNT(b.x)], 1u);
    return b;
}
__device__ __forceinline__ void xcd_barrier_complete(unsigned* bar, unsigned x, unsigned& nloc, unsigned& nx) {
    const unsigned G = gridDim.x * gridDim.y * gridDim.z;
    unsigned sum, cnt, mine, sp = 0u;
    for (;;) {
        sum = 0u; cnt = 0u; mine = 0u;
#pragma unroll
        for (unsigned j = 0; j < 16; ++j) { const unsigned c = xb_ld(&bar[XB_XCNT(j)]); sum += c; cnt += (c > 0u) ? 1u : 0u; mine = (j == x) ? c : mine; }
        if (sum == G) break;
        __builtin_amdgcn_s_sleep(1);
        if ((++sp & 255u) == 0u) { if (xb_ld(&bar[XB_TMO])) break; if (sp > XB_SPIN_CAP) { atomicAdd(&bar[XB_TMO], 1u); break; } }
    }
    nloc = mine > 0u ? mine : 1u; nx = cnt > 0u ? cnt : 1u;
}
__device__ __forceinline__ void xcd_barrier(const XcdBarrier& b) {
    asm volatile("s_waitcnt vmcnt(0)" ::: "memory");
    __syncthreads();
    if (threadIdx.x == 0) {
        unsigned* bar = b.bar;
        __builtin_amdgcn_s_waitcnt(0);
        unsigned nloc = b.st[0], nx = b.st[1];
        if (nloc == 0u) { xcd_barrier_complete(bar, b.x, nloc, nx); b.st[0] = nloc; b.st[1] = nx; }
        const unsigned old = xb_add(&bar[XB_XSUB(b.x)], 1u);
        const unsigned gen = old / nloc;
        if (old + 1u == (gen + 1u) * nloc) {
            __builtin_amdgcn_fence(__ATOMIC_RELEASE, "agent");
            asm volatile("s_waitcnt vmcnt(0)" ::: "memory");
            const unsigned og = xb_add(&bar[XB_TOP], 1u);
            const unsigned tg = og / nx;
            if (og + 1u == (tg + 1u) * nx) xb_add(&bar[XB_TOPGEN], 1u);
            else XB_SPIN(xb_ld(&bar[XB_TOPGEN]) == tg, bar);
            __builtin_amdgcn_fence(__ATOMIC_ACQUIRE, "agent");
            asm volatile("s_waitcnt vmcnt(0)" ::: "memory");
        } else {
            XB_SPIN(xb_ld(&bar[XB_TOPGEN]) == gen, bar);
            __builtin_amdgcn_fence(__ATOMIC_ACQUIRE, "agent");
            asm volatile("s_waitcnt vmcnt(0)" ::: "memory");
        }
    }
    __syncthreads();
}

__device__ __forceinline__ void conv_item(const float* W, int ldw, int K, int srccol0, GAS bf16_t* WT, int dstrow0, LAS float* scr, int kb, int lane, const float* gain) {
    const int k0 = 64 * kb; const GAS float* Wg = (const GAS float*)W; const GAS float* gg = (const GAS float*)gain;
    const int kr = lane >> 3, nq = lane & 7;
    f32x4 v[8];
#pragma unroll
    for (int i = 0; i < 8; ++i) v[i] = *(const GAS f32x4*)(Wg + (size_t)(k0 + 8 * i + kr) * ldw + srccol0 + 4 * nq);
    if (gain) {
#pragma unroll
        for (int i = 0; i < 8; ++i) v[i] = v[i] * gg[k0 + 8 * i + kr]; }
#pragma unroll
    for (int i = 0; i < 8; ++i) { LAS float* s = scr + (8 * i + kr) * 33 + 4 * nq; s[0] = v[i].x; s[1] = v[i].y; s[2] = v[i].z; s[3] = v[i].w; }
    LDS_WAIT(); asm volatile("" ::: "memory");
    const int c = lane & 7;
#pragma unroll
    for (int j = 0; j < 4; ++j) { const int n = (lane >> 3) + 8 * j; const LAS float* s = scr + (8 * c) * 33 + n;
        u32x4 o; o.x = pk2(s[0 * 33], s[1 * 33]); o.y = pk2(s[2 * 33], s[3 * 33]); o.z = pk2(s[4 * 33], s[5 * 33]); o.w = pk2(s[6 * 33], s[7 * 33]);
        *(GAS u32x4*)(WT + (size_t)(dstrow0 + n) * K + k0 + 8 * c) = o; }
    LDS_WAIT(); asm volatile("" ::: "memory");
}
__device__ __forceinline__ bool conv_job(int& r, const float* W, int ldw, int K, int c0, int type, int ncols, GAS bf16_t* WT, int row0, LAS float* scr, int lane, const float* gain) {
    const int nblk = ncols / 32, nitems = (K / 64) * nblk;
    if (r >= nitems) { r -= nitems; return false; }
    const int kb = r / nblk, n0 = 32 * (r % nblk);
    const int src = type == 0 ? c0 + n0 : c0 + (n0 >> 6) * 128 + (n0 & 63);
    conv_item(W, ldw, K, src, WT, row0 + n0, scr, kb, lane, gain);
    return true;
}
__device__ __forceinline__ void rms_row_bf16(const float* xrow, const float* g, GAS bf16_t* orow, int lane) {
    const GAS f32x4* xr = (const GAS f32x4*)xrow + lane; const GAS f32x4* gr = (const GAS f32x4*)g + lane;
    f32x4 v[4]; float s = 0.f;
#pragma unroll
    for (int j = 0; j < 4; ++j) { v[j] = xr[64 * j]; s += (v[j].x * v[j].x + v[j].y * v[j].y) + (v[j].z * v[j].z + v[j].w * v[j].w); }
    const float rs = 1.0f / sqrtf(wave_sum(s, lane) * (1.0f / 1024.0f) + EPS);
    GAS unsigned long long* o8 = (GAS unsigned long long*)orow + lane;
#pragma unroll
    for (int j = 0; j < 4; ++j) { const f32x4 gv = gr[64 * j]; const f32x4 y = v[j] * rs * gv;
        o8[64 * j] = (unsigned long long)pk2(y.x, y.y) | ((unsigned long long)pk2(y.z, y.w) << 32); }
}
__device__ __forceinline__ void copy_row_bf16_ssq(const float* xrow, GAS bf16_t* orow, GAS float* ssq16, int lane) {
    const GAS f32x4* xr = (const GAS f32x4*)xrow + lane;
    float s = 0.f;
    GAS unsigned long long* o8 = (GAS unsigned long long*)orow + lane;
#pragma unroll
    for (int j = 0; j < 4; ++j) { const f32x4 v = xr[64 * j]; const unsigned a = pk2(v.x, v.y), b = pk2(v.z, v.w);
        o8[64 * j] = (unsigned long long)a | ((unsigned long long)b << 32);
        const float r0 = bf2f(a & 0xffffu), r1 = bf2f(a >> 16), r2 = bf2f(b & 0xffffu), r3 = bf2f(b >> 16); s += (r0 * r0 + r1 * r1) + (r2 * r2 + r3 * r3); }
    s = wave_sum(s, lane);
    if (lane < 16) ssq16[lane] = lane == 0 ? s : 0.f;
}
__device__ __forceinline__ void rms_row_out(const GAS bf16_t* xrow, const float* g, float* orow, int lane) {
    const GAS u32x4* xr = (const GAS u32x4*)xrow + lane; const GAS f32x4* gr = (const GAS f32x4*)g; GAS f32x4* o = (GAS f32x4*)orow;
    float v[2][8]; float s = 0.f;
#pragma unroll
    for (int j = 0; j < 2; ++j) { const u32x4 w = xr[64 * j];
#pragma unroll
        for (int e = 0; e < 4; ++e) { v[j][2 * e] = bf2f(w[e] & 0xffffu); v[j][2 * e + 1] = bf2f(w[e] >> 16); s += v[j][2 * e] * v[j][2 * e] + v[j][2 * e + 1] * v[j][2 * e + 1]; } }
    const float rs = 1.0f / sqrtf(wave_sum(s, lane) * (1.0f / 1024.0f) + EPS);
#pragma unroll
    for (int j = 0; j < 2; ++j) { const int i4 = 128 * j + 2 * lane; const f32x4 g0 = gr[i4], g1 = gr[i4 + 1];
        o[i4] = (f32x4){v[j][0] * rs * g0.x, v[j][1] * rs * g0.y, v[j][2] * rs * g0.z, v[j][3] * rs * g0.w};
        o[i4 + 1] = (f32x4){v[j][4] * rs * g1.x, v[j][5] * rs * g1.y, v[j][6] * rs * g1.z, v[j][7] * rs * g1.w}; }
}
__device__ __forceinline__ void sincos_acc(float ang, float& sn, float& cs) {
    const double a = (double)ang; const double kd = __builtin_rint(a * 0.6366197723675814); const int k = (int)kd;
    const double r = (a - kd * 1.5707963267948966) - kd * 6.123233995736766e-17, r2 = r * r;
    const double sp = r * (1.0 + r2 * (-1.0 / 6 + r2 * (1.0 / 120 + r2 * (-1.0 / 5040 + r2 * (1.0 / 362880 + r2 * (-1.0 / 39916800))))));
    const double cp = 1.0 + r2 * (-0.5 + r2 * (1.0 / 24 + r2 * (-1.0 / 720 + r2 * (1.0 / 40320 + r2 * (-1.0 / 3628800 + r2 * (1.0 / 479001600))))));
    const int q = k & 3;
    const double s_ = (q == 0) ? sp : (q == 1) ? cp : (q == 2) ? -sp : -cp;
    const double c_ = (q == 0) ? cp : (q == 1) ? -sp : (q == 2) ? -cp : sp;
    sn = (float)s_; cs = (float)c_;
}

namespace att {
constexpr int KROW = 208, VROW = 144, KT_BYTES = 64 * KROW, VT_BYTES = 64 * VROW, BUF_BYTES = KT_BYTES + VT_BYTES;
struct Stage { u32x4 k1, k2, v; };
#define ATT_RD(F, BASE, OFF) asm volatile("ds_read_b128 %0, %1 offset:" #OFF : "=v"(F) : "v"(BASE))
#define ATT_WT(N, F) asm volatile("s_waitcnt lgkmcnt(" #N ")" : "+v"(F))
__device__ __forceinline__ void att_mseg_sp(unsigned kb, unsigned vb, const bf16x8 (&qf)[6], const f32x16& negm, f32x16& s0, f32x16& s1, const u32x4& w0, const u32x4& w1, const u32x4& w2, const u32x4& w3, f32x16& o0, f32x16& o1) {
    bf16x8 f0, f1, f2, f3, f4, f5;
    const bf16x8 p0 = __builtin_bit_cast(bf16x8, w0), p1 = __builtin_bit_cast(bf16x8, w1), p2 = __builtin_bit_cast(bf16x8, w2), p3 = __builtin_bit_cast(bf16x8, w3);
    ATT_RD(f0, kb, 0); ATT_RD(f1, kb, 6656); ATT_RD(f2, vb, 0); ATT_RD(f3, vb, 4608); ATT_RD(f4, kb, 32);
    ATT_WT(4, f0); s0 = __builtin_amdgcn_mfma_f32_32x32x16_bf16(f0, qf[0], negm, 0, 0, 0); ATT_RD(f5, kb, 6688);
    ATT_WT(4, f1); s1 = __builtin_amdgcn_mfma_f32_32x32x16_bf16(f1, qf[0], negm, 0, 0, 0); ATT_RD(f0, vb, 32);
    ATT_WT(4, f2); o0 = __builtin_amdgcn_mfma_f32_32x32x16_bf16(f2, p0, o0, 0, 0, 0); ATT_RD(f1, vb, 4640);
    ATT_WT(4, f3); o1 = __builtin_amdgcn_mfma_f32_32x32x16_bf16(f3, p0, o1, 0, 0, 0); ATT_RD(f2, kb, 64);
    ATT_WT(4, f4); s0 = __builtin_amdgcn_mfma_f32_32x32x16_bf16(f4, qf[1], s0, 0, 0, 0); ATT_RD(f3, kb, 6720);
    ATT_WT(4, f5); s1 = __builtin_amdgcn_mfma_f32_32x32x16_bf16(f5, qf[1], s1, 0, 0, 0); ATT_RD(f4, vb, 64);
    ATT_WT(4, f0); o0 = __builtin_amdgcn_mfma_f32_32x32x16_bf16(f0, p1, o0, 0, 0, 0); ATT_RD(f5, vb, 4672);
    ATT_WT(4, f1); o1 = __builtin_amdgcn_mfma_f32_32x32x16_bf16(f1, p1, o1, 0, 0, 0); ATT_RD(f0, kb, 96);
    ATT_WT(4, f2); s0 = __builtin_amdgcn_mfma_f32_32x32x16_bf16(f2, qf[2], s0, 0, 0, 0); ATT_RD(f1, kb, 6752);
    ATT_WT(4, f3); s1 = __builtin_amdgcn_mfma_f32_32x32x16_bf16(f3, qf[2], s1, 0, 0, 0); ATT_RD(f2, vb, 96);
    ATT_WT(4, f4); o0 = __builtin_amdgcn_mfma_f32_32x32x16_bf16(f4, p2, o0, 0, 0, 0); ATT_RD(f3, vb, 4704);
    ATT_WT(4, f5); o1 = __builtin_amdgcn_mfma_f32_32x32x16_bf16(f5, p2, o1, 0, 0, 0); ATT_RD(f4, kb, 128);
    ATT_WT(4, f0); s0 = __builtin_amdgcn_mfma_f32_32x32x16_bf16(f0, qf[3], s0, 0, 0, 0); ATT_RD(f5, kb, 6784);
    ATT_WT(4, f1); s1 = __builtin_amdgcn_mfma_f32_32x32x16_bf16(f1, qf[3], s1, 0, 0, 0); ATT_RD(f0, kb, 160);
    ATT_WT(4, f2); o0 = __builtin_amdgcn_mfma_f32_32x32x16_bf16(f2, p3, o0, 0, 0, 0); ATT_RD(f1, kb, 6816);
    ATT_WT(4, f3); o1 = __builtin_amdgcn_mfma_f32_32x32x16_bf16(f3, p3, o1, 0, 0, 0);
    ATT_WT(3, f4); s0 = __builtin_amdgcn_mfma_f32_32x32x16_bf16(f4, qf[4], s0, 0, 0, 0);
    ATT_WT(2, f5); s1 = __builtin_amdgcn_mfma_f32_32x32x16_bf16(f5, qf[4], s1, 0, 0, 0);
    ATT_WT(1, f0); s0 = __builtin_amdgcn_mfma_f32_32x32x16_bf16(f0, qf[5], s0, 0, 0, 0);
    ATT_WT(0, f1); s1 = __builtin_amdgcn_mfma_f32_32x32x16_bf16(f1, qf[5], s1, 0, 0, 0);
}
__device__ __forceinline__ void att_mseg_s(unsigned kb, const bf16x8 (&qf)[6], const f32x16& negm, f32x16& s0, f32x16& s1) {
    bf16x8 f0, f1, f2, f3, f4, f5;
    ATT_RD(f0, kb, 0); ATT_RD(f1, kb, 6656); ATT_RD(f2, kb, 32); ATT_RD(f3, kb, 6688); ATT_RD(f4, kb, 64);
    ATT_WT(4, f0); s0 = __builtin_amdgcn_mfma_f32_32x32x16_bf16(f0, qf[0], negm, 0, 0, 0); ATT_RD(f5, kb, 6720);
    ATT_WT(4, f1); s1 = __builtin_amdgcn_mfma_f32_32x32x16_bf16(f1, qf[0], negm, 0, 0, 0); ATT_RD(f0, kb, 96);
    ATT_WT(4, f2); s0 = __builtin_amdgcn_mfma_f32_32x32x16_bf16(f2, qf[1], s0, 0, 0, 0); ATT_RD(f1, kb, 6752);
    ATT_WT(4, f3); s1 = __builtin_amdgcn_mfma_f32_32x32x16_bf16(f3, qf[1], s1, 0, 0, 0); ATT_RD(f2, kb, 128);
    ATT_WT(4, f4); s0 = __builtin_amdgcn_mfma_f32_32x32x16_bf16(f4, qf[2], s0, 0, 0, 0); ATT_RD(f3, kb, 6784);
    ATT_WT(4, f5); s1 = __builtin_amdgcn_mfma_f32_32x32x16_bf16(f5, qf[2], s1, 0, 0, 0); ATT_RD(f4, kb, 160);
    ATT_WT(4, f0); s0 = __builtin_amdgcn_mfma_f32_32x32x16_bf16(f0, qf[3], s0, 0, 0, 0); ATT_RD(f5, kb, 6816);
    ATT_WT(4, f1); s1 = __builtin_amdgcn_mfma_f32_32x32x16_bf16(f1, qf[3], s1, 0, 0, 0);
    ATT_WT(3, f2); s0 = __builtin_amdgcn_mfma_f32_32x32x16_bf16(f2, qf[4], s0, 0, 0, 0);
    ATT_WT(2, f3); s1 = __builtin_amdgcn_mfma_f32_32x32x16_bf16(f3, qf[4], s1, 0, 0, 0);
    ATT_WT(1, f4); s0 = __builtin_amdgcn_mfma_f32_32x32x16_bf16(f4, qf[5], s0, 0, 0, 0);
    ATT_WT(0, f5); s1 = __builtin_amdgcn_mfma_f32_32x32x16_bf16(f5, qf[5], s1, 0, 0, 0);
}
__device__ __forceinline__ void att_mseg_sp(unsigned kb, unsigned vb, const bf16x8 (&qf)[4], const f32x16& negm, f32x16& s0, f32x16& s1, const u32x4& w0, const u32x4& w1, const u32x4& w2, const u32x4& w3, f32x16& o0, f32x16& o1) {
    bf16x8 f0, f1, f2, f3, f4, f5;
    const bf16x8 p0 = __builtin_bit_cast(bf16x8, w0), p1 = __builtin_bit_cast(bf16x8, w1), p2 = __builtin_bit_cast(bf16x8, w2), p3 = __builtin_bit_cast(bf16x8, w3);
    ATT_RD(f0, kb, 0); ATT_RD(f1, kb, 6656); ATT_RD(f2, vb, 0); ATT_RD(f3, vb, 4608); ATT_RD(f4, kb, 32);
    ATT_WT(4, f0); s0 = __builtin_amdgcn_mfma_f32_32x32x16_bf16(f0, qf[0], negm, 0, 0, 0); ATT_RD(f5, kb, 6688);
    ATT_WT(4, f1); s1 = __builtin_amdgcn_mfma_f32_32x32x16_bf16(f1, qf[0], negm, 0, 0, 0); ATT_RD(f0, vb, 32);
    ATT_WT(4, f2); o0 = __builtin_amdgcn_mfma_f32_32x32x16_bf16(f2, p0, o0, 0, 0, 0); ATT_RD(f1, vb, 4640);
    ATT_WT(4, f3); o1 = __builtin_amdgcn_mfma_f32_32x32x16_bf16(f3, p0, o1, 0, 0, 0); ATT_RD(f2, kb, 64);
    ATT_WT(4, f4); s0 = __builtin_amdgcn_mfma_f32_32x32x16_bf16(f4, qf[1], s0, 0, 0, 0); ATT_RD(f3, kb, 6720);
    ATT_WT(4, f5); s1 = __builtin_amdgcn_mfma_f32_32x32x16_bf16(f5, qf[1], s1, 0, 0, 0); ATT_RD(f4, vb, 64);
    ATT_WT(4, f0); o0 = __builtin_amdgcn_mfma_f32_32x32x16_bf16(f0, p1, o0, 0, 0, 0); ATT_RD(f5, vb, 4672);
    ATT_WT(4, f1); o1 = __builtin_amdgcn_mfma_f32_32x32x16_bf16(f1, p1, o1, 0, 0, 0); ATT_RD(f0, kb, 96);
    ATT_WT(4, f2); s0 = __builtin_amdgcn_mfma_f32_32x32x16_bf16(f2, qf[2], s0, 0, 0, 0); ATT_RD(f1, kb, 6752);
    ATT_WT(4, f3); s1 = __builtin_amdgcn_mfma_f32_32x32x16_bf16(f3, qf[2], s1, 0, 0, 0); ATT_RD(f2, vb, 96);
    ATT_WT(4, f4); o0 = __builtin_amdgcn_mfma_f32_32x32x16_bf16(f4, p2, o0, 0, 0, 0); ATT_RD(f3, vb, 4704);
    ATT_WT(4, f5); o1 = __builtin_amdgcn_mfma_f32_32x32x16_bf16(f5, p2, o1, 0, 0, 0);
    ATT_WT(3, f0); s0 = __builtin_amdgcn_mfma_f32_32x32x16_bf16(f0, qf[3], s0, 0, 0, 0);
    ATT_WT(2, f1); s1 = __builtin_amdgcn_mfma_f32_32x32x16_bf16(f1, qf[3], s1, 0, 0, 0);
    ATT_WT(1, f2); o0 = __builtin_amdgcn_mfma_f32_32x32x16_bf16(f2, p3, o0, 0, 0, 0);
    ATT_WT(0, f3); o1 = __builtin_amdgcn_mfma_f32_32x32x16_bf16(f3, p3, o1, 0, 0, 0);
}
__device__ __forceinline__ void att_mseg_s(unsigned kb, const bf16x8 (&qf)[4], const f32x16& negm, f32x16& s0, f32x16& s1) {
    bf16x8 f0, f1, f2, f3, f4, f5;
    ATT_RD(f0, kb, 0); ATT_RD(f1, kb, 6656); ATT_RD(f2, kb, 32); ATT_RD(f3, kb, 6688); ATT_RD(f4, kb, 64);
    ATT_WT(4, f0); s0 = __builtin_amdgcn_mfma_f32_32x32x16_bf16(f0, qf[0], negm, 0, 0, 0); ATT_RD(f5, kb, 6720);
    ATT_WT(4, f1); s1 = __builtin_amdgcn_mfma_f32_32x32x16_bf16(f1, qf[0], negm, 0, 0, 0); ATT_RD(f0, kb, 96);
    ATT_WT(4, f2); s0 = __builtin_amdgcn_mfma_f32_32x32x16_bf16(f2, qf[1], s0, 0, 0, 0); ATT_RD(f1, kb, 6752);
    ATT_WT(4, f3); s1 = __builtin_amdgcn_mfma_f32_32x32x16_bf16(f3, qf[1], s1, 0, 0, 0);
    ATT_WT(3, f4); s0 = __builtin_amdgcn_mfma_f32_32x32x16_bf16(f4, qf[2], s0, 0, 0, 0);
    ATT_WT(2, f5); s1 = __builtin_amdgcn_mfma_f32_32x32x16_bf16(f5, qf[2], s1, 0, 0, 0);
    ATT_WT(1, f0); s0 = __builtin_amdgcn_mfma_f32_32x32x16_bf16(f0, qf[3], s0, 0, 0, 0);
    ATT_WT(0, f1); s1 = __builtin_amdgcn_mfma_f32_32x32x16_bf16(f1, qf[3], s1, 0, 0, 0);
}
__device__ __forceinline__ void att_mseg_p(unsigned vb, const u32x4& w0, const u32x4& w1, const u32x4& w2, const u32x4& w3, f32x16& o0, f32x16& o1) {
    bf16x8 f0, f1, f2, f3, f4, f5;
    const bf16x8 p0 = __builtin_bit_cast(bf16x8, w0), p1 = __builtin_bit_cast(bf16x8, w1), p2 = __builtin_bit_cast(bf16x8, w2), p3 = __builtin_bit_cast(bf16x8, w3);
    ATT_RD(f0, vb, 0); ATT_RD(f1, vb, 4608); ATT_RD(f2, vb, 32); ATT_RD(f3, vb, 4640); ATT_RD(f4, vb, 64);
    ATT_WT(4, f0); o0 = __builtin_amdgcn_mfma_f32_32x32x16_bf16(f0, p0, o0, 0, 0, 0); ATT_RD(f5, vb, 4672);
    ATT_WT(4, f1); o1 = __builtin_amdgcn_mfma_f32_32x32x16_bf16(f1, p0, o1, 0, 0, 0); ATT_RD(f0, vb, 96);
    ATT_WT(4, f2); o0 = __builtin_amdgcn_mfma_f32_32x32x16_bf16(f2, p1, o0, 0, 0, 0); ATT_RD(f1, vb, 4704);
    ATT_WT(4, f3); o1 = __builtin_amdgcn_mfma_f32_32x32x16_bf16(f3, p1, o1, 0, 0, 0);
    ATT_WT(3, f4); o0 = __builtin_amdgcn_mfma_f32_32x32x16_bf16(f4, p2, o0, 0, 0, 0);
    ATT_WT(2, f5); o1 = __builtin_amdgcn_mfma_f32_32x32x16_bf16(f5, p2, o1, 0, 0, 0);
    ATT_WT(1, f0); o0 = __builtin_amdgcn_mfma_f32_32x32x16_bf16(f0, p3, o0, 0, 0, 0);
    ATT_WT(0, f1); o1 = __builtin_amdgcn_mfma_f32_32x32x16_bf16(f1, p3, o1, 0, 0, 0);
}
#undef ATT_RD
#undef ATT_WT
template <int MODE>
__device__ __forceinline__ void att_softmax(int t, bool first, f32x16& s0, f32x16& s1, f32x16& o0, f32x16& o1, float& lsum, f32x16& negm, u32x4& w0, u32x4& w1, u32x4& w2, u32x4& w3,
                                            int qw) {
    const int key0 = t * 64;
    if (MODE == 0 && key0 + 63 > qw) {
        const int l_ = lane_id_opaque(), qi = qw + (l_ & 31), hh = l_ >> 5;
#pragma unroll
        for (int i = 0; i < 16; ++i) { const int key = key0 + (i & 3) + 8 * (i >> 2) + 4 * hh; if (key > qi) s0[i] = -INFINITY; if (key + 32 > qi) s1[i] = -INFINITY; }
    }
    float a = fmaxf(fmaxf(s0[0], s0[1]), s1[0]), b = fmaxf(fmaxf(s0[2], s0[3]), s1[1]);
    a = fmaxf(fmaxf(a, s1[2]), s1[3]);
#pragma unroll
    for (int i = 4; i < 16; i += 4) { a = fmaxf(fmaxf(a, s0[i]), s0[i + 1]); b = fmaxf(fmaxf(b, s0[i + 2]), s0[i + 3]); a = fmaxf(fmaxf(a, s1[i]), s1[i + 1]); b = fmaxf(fmaxf(b, s1[i + 2]), s1[i + 3]); }
    float smax = fmaxf(a, b);
    { const auto rr = __builtin_amdgcn_permlane32_swap(__builtin_bit_cast(unsigned, smax), __builtin_bit_cast(unsigned, smax), false, false);
      smax = fmaxf(__builtin_bit_cast(float, (unsigned)rr[0]), __builtin_bit_cast(float, (unsigned)rr[1])); }
    if (first || (__builtin_amdgcn_ballot_w64(smax > RESCALE_THR) != 0ull)) {
        const float d = first ? smax : fmaxf(smax, 0.f);
#pragma unroll
        for (int i = 0; i < 16; ++i) { s0[i] -= d; s1[i] -= d; negm[i] -= d; }
        if (!first) { const float alpha = __builtin_amdgcn_exp2f(-d);
#pragma unroll
            for (int i = 0; i < 16; ++i) { o0[i] *= alpha; o1[i] *= alpha; } lsum *= alpha; }
    }
#pragma unroll
    for (int i = 0; i < 16; ++i) { s0[i] = __builtin_amdgcn_exp2f(s0[i]); s1[i] = __builtin_amdgcn_exp2f(s1[i]); }
    __builtin_amdgcn_sched_barrier(0);
    w0[0] = cvtpk(s0[0], s0[1]); w0[1] = cvtpk(s0[2], s0[3]); w0[2] = cvtpk(s0[4], s0[5]); w0[3] = cvtpk(s0[6], s0[7]);
    w1[0] = cvtpk(s0[8], s0[9]); w1[1] = cvtpk(s0[10], s0[11]); w1[2] = cvtpk(s0[12], s0[13]); w1[3] = cvtpk(s0[14], s0[15]);
    w2[0] = cvtpk(s1[0], s1[1]); w2[1] = cvtpk(s1[2], s1[3]); w2[2] = cvtpk(s1[4], s1[5]); w2[3] = cvtpk(s1[6], s1[7]);
    w3[0] = cvtpk(s1[8], s1[9]); w3[1] = cvtpk(s1[10], s1[11]); w3[2] = cvtpk(s1[12], s1[13]); w3[3] = cvtpk(s1[14], s1[15]);
    float ls_a = fadd_s(s0[0], s0[1]), ls_b = fadd_s(s0[2], s0[3]), ls_c = fadd_s(s1[0], s1[1]), ls_d = fadd_s(s1[2], s1[3]);
#pragma unroll
    for (int i = 4; i < 16; i += 4) { ls_a = fadd_s(ls_a, fadd_s(s0[i], s0[i + 1])); ls_b = fadd_s(ls_b, fadd_s(s0[i + 2], s0[i + 3])); ls_c = fadd_s(ls_c, fadd_s(s1[i], s1[i + 1])); ls_d = fadd_s(ls_d, fadd_s(s1[i + 2], s1[i + 3])); }
    ls_a = fadd_s(ls_a, ls_c); ls_b = fadd_s(ls_b, ls_d);
    lsum += ls_a + ls_b;
}
template <int DK, int MODE>
__device__ __forceinline__ void attn_unit(LAS unsigned char* lds, const GAS bf16_t* Qp, int ldq, const GAS bf16_t* K1, int ldk1, const GAS bf16_t* K2, int ldk2, const GAS bf16_t* Vt, int ldv,
                                          GAS bf16_t* O, int ldo, int q0, int t_lo, int t_hi, int tid) {
    const int wave = __builtin_amdgcn_readfirstlane(tid >> 6), lane = tid & 63, r = lane & 31, hh = lane >> 5;
    const int qw = q0 + 32 * wave, qi = qw + r;
    const bool late = wave >= 4;
    bf16x8 qf[DK / 16];
#pragma unroll
    for (int s = 0; s < DK / 16; ++s) qf[s] = *(const GAS bf16x8*)(Qp + (size_t)qi * ldq + 16 * s + 8 * hh);
    f32x16 o0, o1, negm, s0, s1; u32x4 w0, w1, w2, w3; float lsum = 0.f;
#pragma unroll
    for (int i = 0; i < 16; ++i) { o0[i] = 0.f; o1[i] = 0.f; negm[i] = 0.f; s0[i] = 0.f; s1[i] = 0.f; }
    w0 = (u32x4){0u, 0u, 0u, 0u}; w1 = w0; w2 = w0; w3 = w0;
    const int sk_row = tid >> 3, sk_ch = tid & 7;
    const unsigned vk1 = (unsigned)(sk_row * ldk1 + sk_ch * 8) * 2u, vk2 = (unsigned)(((tid >> 2) & 63) * ldk2 + (tid & 3) * 8) * 2u, vv = (unsigned)(sk_row * 64 + sk_ch * 8) * 2u;
    const size_t vts = (size_t)ldv * 64;
    const int kw_off = sk_row * KROW + sk_ch * 16, k2w_off = ((tid >> 2) & 63) * KROW + 128 + (tid & 3) * 16, vw_off = KT_BYTES + sk_row * VROW + (sk_ch >> 1) * 32 + (sk_ch & 1) * 8;
    const bool st_k2 = wave < 4;
    Stage A, B; A.k2 = (u32x4){0u, 0u, 0u, 0u}; B.k2 = A.k2;
#define ATT_LOAD1(R, tile) do { const int tl_ = (tile) < t_hi ? (tile) : t_hi - 1; const size_t k_ = (size_t)tl_ * 64; R.k1 = *(const GAS u32x4*)((const GAS char*)(K1 + k_ * ldk1) + vk1); \
        if (DK == 96) R.k2 = *(const GAS u32x4*)((const GAS char*)(K2 + k_ * ldk2) + vk2); R.v = *(const GAS u32x4*)((const GAS char*)(Vt + (size_t)tl_ * vts) + vv); } while (0)
#define ATT_STORE1(R, off) do { LAS unsigned char* b_ = lds + (off); *(LAS u32x4*)(b_ + kw_off) = R.k1; if (DK == 96) { if (st_k2) *(LAS u32x4*)(b_ + k2w_off) = R.k2; } \
        *(LAS u32x2*)(b_ + vw_off) = (u32x2){R.v.x, R.v.y}; *(LAS u32x2*)(b_ + vw_off + 16) = (u32x2){R.v.z, R.v.w}; } while (0)
#define ATT_NEED(t_) ((MODE == 2) || ((t_) * 64 <= qw + 31))
#define ATT_BUFO(t_) (((t_) & 3) * BUF_BYTES)
#define ATT_BAR  do { __builtin_amdgcn_sched_barrier(0); asm volatile("" ::: "memory"); __builtin_amdgcn_s_barrier(); asm volatile("" ::: "memory"); __builtin_amdgcn_sched_barrier(0); } while (0)
#define ATT_BARW do { __builtin_amdgcn_sched_barrier(0); asm volatile("s_waitcnt lgkmcnt(0)" ::: "memory"); __builtin_amdgcn_s_barrier(); asm volatile("" ::: "memory"); __builtin_amdgcn_sched_barrier(0); } while (0)
#define ATT_MSEG(u_) do { const unsigned kb_ = kfrag_a + ATT_BUFO(u_); const unsigned vb_ = vfrag_a + ATT_BUFO((u_) - 1); \
        if (ATT_NEED(u_)) att_mseg_sp(kb_, vb_, qf, negm, s0, s1, w0, w1, w2, w3, o0, o1); \
        else if (ATT_NEED((u_) - 1)) att_mseg_p(vb_, w0, w1, w2, w3, o0, o1); } while (0)
    const unsigned kfrag_a = (unsigned)(size_t)lds + (unsigned)(r * KROW + hh * 16), vfrag_a = (unsigned)(size_t)lds + (unsigned)(KT_BYTES + r * VROW + hh * 16);
    ATT_LOAD1(A, t_lo); ATT_LOAD1(B, t_lo + 1);
    ATT_STORE1(A, ATT_BUFO(t_lo)); ATT_STORE1(B, ATT_BUFO(t_lo + 1));
    ATT_LOAD1(A, t_lo + 2);
    ATT_BARW;
    if (late) ATT_BAR;
    if (ATT_NEED(t_lo)) att_mseg_s(kfrag_a + ATT_BUFO(t_lo), qf, negm, s0, s1);
    ATT_BAR;
    for (int t = t_lo; ; t += 2) {
        if (ATT_NEED(t)) att_softmax<MODE>(t, t == t_lo, s0, s1, o0, o1, lsum, negm, w0, w1, w2, w3, qw);
        __builtin_amdgcn_sched_barrier(0);
        if (t + 2 < t_hi) ATT_STORE1(A, ATT_BUFO(t + 2));
        ATT_LOAD1(A, t + 3);
        ATT_BARW;
        ATT_MSEG(t + 1);
        ATT_BAR;
        if (ATT_NEED(t + 1)) att_softmax<MODE>(t + 1, false, s0, s1, o0, o1, lsum, negm, w0, w1, w2, w3, qw);
        __builtin_amdgcn_sched_barrier(0);
        if (t + 3 < t_hi) ATT_STORE1(A, ATT_BUFO(t + 3));
        ATT_LOAD1(A, t + 4);
        ATT_BARW;
        if (t + 2 >= t_hi) break;
        ATT_MSEG(t + 2);
        ATT_BAR;
    }
    if (ATT_NEED(t_hi - 1)) att_mseg_p(vfrag_a + ATT_BUFO(t_hi - 1), w0, w1, w2, w3, o0, o1);
    if (!late) ATT_BAR;
#undef ATT_LOAD1
#undef ATT_STORE1
#undef ATT_NEED
#undef ATT_BUFO
#undef ATT_BAR
#undef ATT_BARW
#undef ATT_MSEG
    float inv;
    { const auto rr = __builtin_amdgcn_permlane32_swap(__builtin_bit_cast(unsigned, lsum), __builtin_bit_cast(unsigned, lsum), false, false);
      inv = 1.0f / (__builtin_bit_cast(float, (unsigned)rr[0]) + __builtin_bit_cast(float, (unsigned)rr[1])); }
    const int le_ = lane_id_opaque();
    GAS bf16_t* op = O + (size_t)(qw + (le_ & 31)) * ldo + 4 * (le_ >> 5);
#pragma unroll
    for (int g = 0; g < 4; ++g) {
        u32x2 w0_, w1_;
        w0_.x = cvtpk(o0[4 * g + 0] * inv, o0[4 * g + 1] * inv); w0_.y = cvtpk(o0[4 * g + 2] * inv, o0[4 * g + 3] * inv);
        w1_.x = cvtpk(o1[4 * g + 0] * inv, o1[4 * g + 1] * inv); w1_.y = cvtpk(o1[4 * g + 2] * inv, o1[4 * g + 3] * inv);
        *(GAS u32x2*)(op + 8 * g) = w0_; *(GAS u32x2*)(op + 32 + 8 * g) = w1_;
    }
}
constexpr int SW_ROW = 144, SW_KT = 64 * SW_ROW, SW_V_OFF = 6 * SW_KT, SW_P_OFF = 12 * SW_KT, SW_BYTES = SW_P_OFF + 6 * 256;
__device__ __forceinline__ void swa_unit(LAS unsigned char* lds, const GAS bf16_t* proj, const GAS bf16_t* Vt, GAS bf16_t* O, int kvh, int q0, const float* sinks, const GAS int* pos, int tid) {
    const int wave = __builtin_amdgcn_readfirstlane(tid >> 6), lane = tid & 63, r = lane & 31, hh = lane >> 5;
    const int qw = q0 + 32 * wave, qi = qw + r;
    const int tl = q0 >= 128 ? (q0 - 128) >> 6 : 0, th = (q0 + 256) >> 6, nt = th - tl;
    {
        const int sk_row = tid >> 3, sk_ch = tid & 7;
        const GAS bf16_t* gk = proj + (size_t)(tl * 64 + sk_row) * PROJ_LD + 768 + kvh * 64 + sk_ch * 8;
        const GAS bf16_t* gv = Vt + ((size_t)tl * 256 + sk_row) * 64 + sk_ch * 8;
        LAS unsigned char* kw = lds + sk_row * SW_ROW + sk_ch * 16; LAS unsigned char* vw = lds + SW_V_OFF + sk_row * SW_ROW + (sk_ch >> 1) * 32 + (sk_ch & 1) * 8;
#pragma unroll
        for (int bt = 0; bt < 2; ++bt) {
            u32x4 k0, k1, k2, v0, v1, v2; const int i0 = 3 * bt;
            k0 = *(const GAS u32x4*)(gk + (size_t)(i0 + 0) * 64 * PROJ_LD); v0 = *(const GAS u32x4*)(gv + (size_t)(i0 + 0) * 256 * 64);
            k1 = *(const GAS u32x4*)(gk + (size_t)(i0 + 1) * 64 * PROJ_LD); v1 = *(const GAS u32x4*)(gv + (size_t)(i0 + 1) * 256 * 64);
            const bool has2 = i0 + 2 < nt;
            k2 = k1; v2 = v1; if (has2) { k2 = *(const GAS u32x4*)(gk + (size_t)(i0 + 2) * 64 * PROJ_LD); v2 = *(const GAS u32x4*)(gv + (size_t)(i0 + 2) * 256 * 64); }
            if (i0 < nt) {
                *(LAS u32x4*)(kw + (i0 + 0) * SW_KT) = k0; *(LAS u32x2*)(vw + (i0 + 0) * SW_KT) = (u32x2){v0.x, v0.y}; *(LAS u32x2*)(vw + (i0 + 0) * SW_KT + 16) = (u32x2){v0.z, v0.w};
                if (i0 + 1 < nt) { *(LAS u32x4*)(kw + (i0 + 1) * SW_KT) = k1; *(LAS u32x2*)(vw + (i0 + 1) * SW_KT) = (u32x2){v1.x, v1.y}; *(LAS u32x2*)(vw + (i0 + 1) * SW_KT + 16) = (u32x2){v1.z, v1.w}; }
                if (has2) { *(LAS u32x4*)(kw + (i0 + 2) * SW_KT) = k2; *(LAS u32x2*)(vw + (i0 + 2) * SW_KT) = (u32x2){v2.x, v2.y}; *(LAS u32x2*)(vw + (i0 + 2) * SW_KT + 16) = (u32x2){v2.z, v2.w}; }
            }
        }
        if (tid < 64 * nt) *(LAS float*)(lds + SW_P_OFF + 4 * tid) = (float)pos[tl * 64 + tid];
    }
    __syncthreads();
    const float posq = (float)pos[qi];
    int ta = qw >= 127 ? ((qw - 127) >> 6) : 0; if (ta < tl) ta = tl; const int tb = (qw + 31) >> 6;
    const int koff = r * SW_ROW + hh * 16;
    for (int g = 0; g < 3; ++g) {
        const int h = kvh * 3 + g;
        const float slope = __builtin_amdgcn_exp2f(-(float)(h + 1) * (8.0f / 12.0f)) * LOG2E, sinkl = sinks[h] * LOG2E;
        bf16x8 q0f, q1f, q2f, q3f;
        { const GAS bf16_t* qp = proj + (size_t)qi * PROJ_LD + h * 64 + 8 * hh; q0f = *(const GAS bf16x8*)qp; q1f = *(const GAS bf16x8*)(qp + 16); q2f = *(const GAS bf16x8*)(qp + 32); q3f = *(const GAS bf16x8*)(qp + 48); }
        const float crow = slope * posq;
        float m = -1e30f, l = 0.f; f32x16 o0, o1;
#pragma unroll
        for (int i = 0; i < 16; ++i) { o0[i] = 0.f; o1[i] = 0.f; }
        for (int t = ta; t <= tb; ++t) {
            const LAS unsigned char* kb = lds + (t - tl) * SW_KT + koff; const LAS unsigned char* vb = kb + SW_V_OFF; const LAS float* pk = (const LAS float*)(lds + SW_P_OFF + (t - tl) * 256);
            f32x16 s0, s1;
#pragma unroll
            for (int i = 0; i < 16; ++i) { s0[i] = 0.f; s1[i] = 0.f; }
            s0 = __builtin_amdgcn_mfma_f32_32x32x16_bf16(*(const LAS bf16x8*)(kb), q0f, s0, 0, 0, 0); s1 = __builtin_amdgcn_mfma_f32_32x32x16_bf16(*(const LAS bf16x8*)(kb + 32 * SW_ROW), q0f, s1, 0, 0, 0);
            s0 = __builtin_amdgcn_mfma_f32_32x32x16_bf16(*(const LAS bf16x8*)(kb + 32), q1f, s0, 0, 0, 0); s1 = __builtin_amdgcn_mfma_f32_32x32x16_bf16(*(const LAS bf16x8*)(kb + 32 * SW_ROW + 32), q1f, s1, 0, 0, 0);
            s0 = __builtin_amdgcn_mfma_f32_32x32x16_bf16(*(const LAS bf16x8*)(kb + 64), q2f, s0, 0, 0, 0); s1 = __builtin_amdgcn_mfma_f32_32x32x16_bf16(*(const LAS bf16x8*)(kb + 32 * SW_ROW + 64), q2f, s1, 0, 0, 0);
            s0 = __builtin_amdgcn_mfma_f32_32x32x16_bf16(*(const LAS bf16x8*)(kb + 96), q3f, s0, 0, 0, 0); s1 = __builtin_amdgcn_mfma_f32_32x32x16_bf16(*(const LAS bf16x8*)(kb + 32 * SW_ROW + 96), q3f, s1, 0, 0, 0);
            const int key0 = t * 64; float smax = -INFINITY;
#pragma unroll
            for (int i = 0; i < 16; ++i) {
                const int kk = (i & 3) + 8 * (i >> 2) + 4 * hh; const int d0 = qi - (key0 + kk), d1 = d0 - 32;
                float v0 = __builtin_fmaf(slope, pk[kk], s0[i]), v1 = __builtin_fmaf(slope, pk[kk + 32], s1[i]);
                if (d0 < 0 || d0 >= 128) v0 = -INFINITY;
                if (d1 < 0 || d1 >= 128) v1 = -INFINITY;
                s0[i] = v0; s1[i] = v1; smax = fmaxf(smax, fmaxf(v0, v1));
            }
            { const auto rr = __builtin_amdgcn_permlane32_swap(__builtin_bit_cast(unsigned, smax), __builtin_bit_cast(unsigned, smax), false, false);
              smax = fmaxf(__builtin_bit_cast(float, (unsigned)rr[0]), __builtin_bit_cast(float, (unsigned)rr[1])); }
            if (__builtin_amdgcn_ballot_w64(smax - m > RESCALE_THR) != 0ull) {
                const float mn = fmaxf(m, smax), alpha = __builtin_amdgcn_exp2f(m - mn); m = mn; l *= alpha;
#pragma unroll
                for (int i = 0; i < 16; ++i) { o0[i] *= alpha; o1[i] *= alpha; }
            }
            float ls = 0.f; u32x4 w0, w1, w2, w3;
#define SW_P4(S, B, W, D) do { const float p0 = __builtin_amdgcn_exp2f(S[B] - m), p1 = __builtin_amdgcn_exp2f(S[B + 1] - m), p2 = __builtin_amdgcn_exp2f(S[B + 2] - m), p3 = __builtin_amdgcn_exp2f(S[B + 3] - m); \
                ls += p0; ls += p1; ls += p2; ls += p3; W[D] = cvtpk(p0, p1); W[D + 1] = cvtpk(p2, p3); } while (0)
            SW_P4(s0, 0, w0, 0); SW_P4(s0, 4, w0, 2); SW_P4(s0, 8, w1, 0); SW_P4(s0, 12, w1, 2);
            SW_P4(s1, 0, w2, 0); SW_P4(s1, 4, w2, 2); SW_P4(s1, 8, w3, 0); SW_P4(s1, 12, w3, 2);
#undef SW_P4
            l += ls;
            o0 = __builtin_amdgcn_mfma_f32_32x32x16_bf16(*(const LAS bf16x8*)(vb), __builtin_bit_cast(bf16x8, w0), o0, 0, 0, 0); o1 = __builtin_amdgcn_mfma_f32_32x32x16_bf16(*(const LAS bf16x8*)(vb + 32 * SW_ROW), __builtin_bit_cast(bf16x8, w0), o1, 0, 0, 0);
            o0 = __builtin_amdgcn_mfma_f32_32x32x16_bf16(*(const LAS bf16x8*)(vb + 32), __builtin_bit_cast(bf16x8, w1), o0, 0, 0, 0); o1 = __builtin_amdgcn_mfma_f32_32x32x16_bf16(*(const LAS bf16x8*)(vb + 32 * SW_ROW + 32), __builtin_bit_cast(bf16x8, w1), o1, 0, 0, 0);
            o0 = __builtin_amdgcn_mfma_f32_32x32x16_bf16(*(const LAS bf16x8*)(vb + 64), __builtin_bit_cast(bf16x8, w2), o0, 0, 0, 0); o1 = __builtin_amdgcn_mfma_f32_32x32x16_bf16(*(const LAS bf16x8*)(vb + 32 * SW_ROW + 64), __builtin_bit_cast(bf16x8, w2), o1, 0, 0, 0);
            o0 = __builtin_amdgcn_mfma_f32_32x32x16_bf16(*(const LAS bf16x8*)(vb + 96), __builtin_bit_cast(bf16x8, w3), o0, 0, 0, 0); o1 = __builtin_amdgcn_mfma_f32_32x32x16_bf16(*(const LAS bf16x8*)(vb + 32 * SW_ROW + 96), __builtin_bit_cast(bf16x8, w3), o1, 0, 0, 0);
        }
        { const auto rr = __builtin_amdgcn_permlane32_swap(__builtin_bit_cast(unsigned, l), __builtin_bit_cast(unsigned, l), false, false);
          l = __builtin_bit_cast(float, (unsigned)rr[0]) + __builtin_bit_cast(float, (unsigned)rr[1]); }
        l += __builtin_amdgcn_exp2f(sinkl + crow - m);
        const float inv = 1.0f / l;
        GAS bf16_t* op = O + (size_t)qi * 1024 + h * 64 + 4 * hh;
#pragma unroll
        for (int gg = 0; gg < 4; ++gg) {
            u32x2 a, b2;
            a.x = cvtpk(o0[4 * gg + 0] * inv, o0[4 * gg + 1] * inv); a.y = cvtpk(o0[4 * gg + 2] * inv, o0[4 * gg + 3] * inv);
            b2.x = cvtpk(o1[4 * gg + 0] * inv, o1[4 * gg + 1] * inv); b2.y = cvtpk(o1[4 * gg + 2] * inv, o1[4 * gg + 3] * inv);
            *(GAS u32x2*)(op + 8 * gg) = a; *(GAS u32x2*)(op + 32 + 8 * gg) = b2;
        }
    }
    __syncthreads();
}
}

__device__ __forceinline__ int opaque_zero() { int z; asm volatile("v_mov_b32 %0, 0" : "=v"(z)); return __builtin_amdgcn_readfirstlane(z); }
typedef const char __attribute__((address_space(4)))* kargp_t;
__device__ __forceinline__ unsigned long long opaque_u64(unsigned long long v) {
    const int lo_s = (int)(unsigned)v, hi_s = (int)(unsigned)(v >> 32); int lo, hi;
    asm volatile("v_mov_b32 %0, %2\n\tv_mov_b32 %1, %3" : "=&v"(lo), "=&v"(hi) : "s"(lo_s), "s"(hi_s));
    return ((unsigned long long)(unsigned)__builtin_amdgcn_readfirstlane(hi) << 32) | (unsigned long long)(unsigned)__builtin_amdgcn_readfirstlane(lo);
}
__device__ __forceinline__ const void* ld_arg(kargp_t kp, int byte_off) {
    return *(const void* const __attribute__((address_space(4)))*)(kp + byte_off);
}
#define INP(i) ((const float*)ld_arg(kp, 8 * (i)))
#define GB(off) ((GAS bf16_t*)(ws + (off)))
#define GF(off) ((GAS float*)(ws + (off)))
#define x_in INP(0)
#define mem INP(1)
#define positions ((const int*)ld_arg(kp, 16))
#define attn_norm_g INP(3)
#define mlp_norm_g INP(4)
#define mem_norm_g INP(5)
#define final_norm_g INP(6)
#define mla_w_in INP(7)
#define mla_q_norm_g INP(8)
#define mla_kv_norm_g INP(9)
#define mla_w_uq INP(10)
#define mla_w_ukv INP(11)
#define swa_w_in INP(12)
#define swa_sinks INP(13)
#define w_mem_kv INP(14)
#define w_o INP(15)
#define mlp_w_up INP(16)
#define mlp_w_down INP(17)
#define xres ((float*)ld_arg(kp, 144))

__device__ __forceinline__ int conv_layer_total(int L) { return ((L & 1) == 0 ? (16 * 29 + 6 * 36 + 4 * 24 + 4 * 24) : (16 * 32 + 16 * 8 + 16 * 8)) + 16 * 8 + 16 * 8 + 16 * 32 + 16 * 128 + 64 * 32; }
__device__ __forceinline__ void conv_layer_item(kargp_t kp, unsigned char* wsb, int L, int it, LAS float* scr, int lane) {
    const int j = L >> 1; int r = it;
    const float* ga = attn_norm_g + L * D;
    if ((L & 1) == 0) {
        if (conv_job(r, mla_w_in + (size_t)j * 1024 * 928, 928, 1024, 0, 0, 928, (GAS bf16_t*)(wsb + WO_IN), 0, scr, lane, ga)) return;
        if (conv_job(r, mla_w_uq + (size_t)j * 384 * 1152, 1152, 384, 0, 0, 1152, (GAS bf16_t*)(wsb + WO_UQ), 0, scr, lane, mla_q_norm_g + j * 384)) return;
        if (conv_job(r, mla_w_ukv + (size_t)j * 256 * 1536, 1536, 256, 0, 1, 768, (GAS bf16_t*)(wsb + WO_UK), 0, scr, lane, mla_kv_norm_g + j * 256)) return;
        if (conv_job(r, mla_w_ukv + (size_t)j * 256 * 1536, 1536, 256, 64, 1, 768, (GAS bf16_t*)(wsb + WO_UV), 0, scr, lane, mla_kv_norm_g + j * 256)) return;
    } else {
        if (conv_job(r, swa_w_in + (size_t)j * 1024 * 1536, 1536, 1024, 0, 0, 1024, (GAS bf16_t*)(wsb + WO_IN), 0, scr, lane, ga)) return;
        if (conv_job(r, swa_w_in + (size_t)j * 1024 * 1536, 1536, 1024, 1280, 0, 256, (GAS bf16_t*)(wsb + WO_IN), 1024, scr, lane, ga)) return;
        if (conv_job(r, swa_w_in + (size_t)j * 1024 * 1536, 1536, 1024, 1024, 0, 256, (GAS bf16_t*)(wsb + WO_V), 0, scr, lane, ga)) return;
    }
    if (conv_job(r, w_mem_kv + (size_t)L * 1024 * 512, 512, 1024, 0, 0, 256, (GAS bf16_t*)(wsb + WO_MK), 0, scr, lane, nullptr)) return;
    if (conv_job(r, w_mem_kv + (size_t)L * 1024 * 512, 512, 1024, 256, 0, 256, (GAS bf16_t*)(wsb + WO_MV), 0, scr, lane, nullptr)) return;
    if (conv_job(r, w_o + (size_t)L * 1024 * 1024, 1024, 1024, 0, 0, 1024, (GAS bf16_t*)(wsb + WO_O), 0, scr, lane, nullptr)) return;
    if (conv_job(r, mlp_w_up + (size_t)L * 1024 * 4096, 4096, 1024, 0, 0, 4096, (GAS bf16_t*)(wsb + WO_UP), 0, scr, lane, mlp_norm_g + L * D)) return;
    (void)conv_job(r, mlp_w_down + (size_t)L * 4096 * 1024, 1024, 4096, 0, 0, 1024, (GAS bf16_t*)(wsb + WO_DN), 0, scr, lane, nullptr);
}

struct Args { const void* in[18]; float* out; unsigned char* ws; int ph_lo, ph_hi; };
constexpr int N_PHASES = 24;

__global__ void __launch_bounds__(NWAVES * 64, 2) trunk_fwd(Args args) {
    extern __shared__ __attribute__((aligned(16))) unsigned char lds_raw[];
    LAS unsigned char* lds = (LAS unsigned char*)lds_raw;
    volatile LAS unsigned* MISC = (volatile LAS unsigned*)(lds + MISC_OFF);
    unsigned* ctl = (unsigned*)(args.ws + WS_CTL);
    const int wave0 = __builtin_amdgcn_readfirstlane(threadIdx.x >> 6);
    for (int u = threadIdx.x; u < (LDS_BYTES - LDSCTL_OFF) / 4; u += NWAVES * 64) ((LAS unsigned*)(lds + LDSCTL_OFF))[u] = 0u;
    __syncthreads();
    unsigned bar_x = 0; (void)bar_x;
#if !MK_PER_PHASE_LAUNCH
    { XcdBarrier b0_ = xcd_barrier_post(ctl + CW_BAR, MISC + 8); bar_x = b0_.x; }
#endif
    const int lo = args.ph_lo, hi = args.ph_hi;
    int ph = 0;

#define PHASE_BEGIN if (ph >= lo && ph < hi) { const int zz = opaque_zero(); unsigned char* ws = (unsigned char*)opaque_u64((unsigned long long)args.ws); \
        kargp_t kp = (kargp_t)opaque_u64((unsigned long long)__builtin_amdgcn_kernarg_segment_ptr()); (void)kp; \
        const int tid = wave0 * 64 + lane_id_opaque(); \
        const int G = (int)gridDim.x + zz, bx = (int)blockIdx.x + zz, vcu = (G % 8 == 0) ? (bx % 8) * (G / 8) + bx / 8 : bx, NGW = G * NWAVES; (void)NGW; const int lane = tid & 63, wave = __builtin_amdgcn_readfirstlane(tid >> 6); \
        const int gw = vcu * NWAVES + wave; LAS float* scr = (LAS float*)(lds + wave * 16384); (void)ws; (void)lane; (void)gw; (void)scr;
#if MK_PER_PHASE_LAUNCH
#define PHASE_END } ++ph;
#else
#define PHASE_END if (ph + 1 < hi) { XcdBarrier b_; b_.bar = (unsigned*)ws + CW_BAR; b_.x = bar_x + (unsigned)zz; b_.st = MISC + 8; xcd_barrier(b_); } } ++ph;
#endif
#define GEMM_RUN(EPI, ...) do { pg8::StaticOrder So; So.init(g.M, g.N, G, bx, rot); EPI E{__VA_ARGS__}; pg8::gemm_phase(lds, g, So, E, wave0); rot += (g.M / 256) * (g.N / 256); } while (0)

    PHASE_BEGIN
        for (int i = bx * (NWAVES * 64) + tid; i < T * 16; i += G * NWAVES * 64) {
            const int t = i >> 4, f = i & 15; const float ang = (float)positions[t] * rope_inv[f];
            float sn, cs; sincos_acc(ang, sn, cs); GF(WS_COS)[i] = cs; GF(WS_SIN)[i] = sn;
        }
        for (int rr = gw; rr < NB * NMEM; rr += NGW) rms_row_bf16(mem + (size_t)rr * D, mem_norm_g, GB(WS_MEMN) + (size_t)rr * D, lane);
        { const int total = conv_layer_total(0); for (int it = gw; it < total; it += NGW) conv_layer_item(kp, ws + WS_WSET, 0, it, scr, lane); }
        for (int rr = gw; rr < T; rr += NGW) copy_row_bf16_ssq(x_in + (size_t)rr * D, GB(WS_XB) + (size_t)rr * D, GF(WS_SSQ) + (size_t)rr * 16, lane);
    PHASE_END

    for (int L = 0; L < DEPTH; ++L) {
        const bool mla = (L & 1) == 0; const int j = L >> 1;
        PHASE_BEGIN
            unsigned char* wsb = ws + WS_WSET + (size_t)(L & 1) * WSET_BYTES; int rot = 0;
            if (mla) {
                pg8::Gemm g{GB(WS_XB), (GAS bf16_t*)(wsb + WO_IN), T, 1024, 1024, 1024, 1024};
                GEMM_RUN(pg8::EpiProjMla, GB(WS_PROJ), PROJ_LD, GF(WS_SSQ), GF(WS_SSQ32), GF(WS_COS), GF(WS_SIN));
            } else {
                { pg8::Gemm g{GB(WS_XB), (GAS bf16_t*)(wsb + WO_IN), T, 1280, 1024, 1024, 1024}; using E_ = pg8::EpiBf16<0, 1, 0, false, true>; GEMM_RUN(E_, GB(WS_PROJ), PROJ_LD, GF(WS_SSQ)); }
                { pg8::Gemm g{(GAS bf16_t*)(wsb + WO_V), GB(WS_XB), 256, T, 1024, 1024, 1024}; using E_ = pg8::EpiBf16<0, 2, 0, true>; GEMM_RUN(E_, GB(WS_VT), 256, GF(WS_SSQ)); }
                { pg8::Gemm g{GB(WS_MEMN), (GAS bf16_t*)(wsb + WO_MK), 1024, 256, 1024, 1024, 1024}; using E_ = pg8::EpiBf16<0, 0, 0>; GEMM_RUN(E_, GB(WS_MEMK), 256, nullptr); }
                { pg8::Gemm g{(GAS bf16_t*)(wsb + WO_MV), GB(WS_MEMN), 256, 1024, 1024, 1024, 1024}; using E_ = pg8::EpiBf16<0, 0, 0, true>; GEMM_RUN(E_, GB(WS_MEMVT), 256, nullptr); }
            }
        PHASE_END
        if (mla) {
            PHASE_BEGIN
                unsigned char* wsb = ws + WS_WSET + (size_t)(L & 1) * WSET_BYTES; int rot = 0;
                const int G_all = G, bx_all = bx, n_memb = G_all >= 64 ? 8 : 0;
                if (bx_all >= n_memb) {
                    const int G = G_all - n_memb, bx = bx_all - n_memb;
                    { pg8::Gemm g{GB(WS_PROJ), (GAS bf16_t*)(wsb + WO_UQ), T, 1280, 384, PROJ_LD, 384}; GEMM_RUN(pg8::EpiRope, GB(WS_Q), QLD, GF(WS_COS), GF(WS_SIN), GF(WS_SSQ32)); }
                    { pg8::Gemm g{GB(WS_PROJ) + 384, (GAS bf16_t*)(wsb + WO_UK), T, 768, 256, PROJ_LD, 256}; using E_ = pg8::EpiBf16<0, 1, 2>; GEMM_RUN(E_, GB(WS_KN), 768, GF(WS_SSQ32)); }
                    { pg8::Gemm g{(GAS bf16_t*)(wsb + WO_UV), GB(WS_PROJ) + 384, 768, T, 256, 256, PROJ_LD}; using E_ = pg8::EpiBf16<0, 2, 2, true>; GEMM_RUN(E_, GB(WS_VT), 768, GF(WS_SSQ32)); }
                }
                if (bx_all < n_memb || n_memb == 0) {
                    const int G = n_memb ? n_memb : G_all, bx = bx_all; int rot = 0;
                    { pg8::Gemm g{GB(WS_MEMN), (GAS bf16_t*)(wsb + WO_MK), 1024, 256, 1024, 1024, 1024}; using E_ = pg8::EpiBf16<0, 0, 0>; GEMM_RUN(E_, GB(WS_MEMK), 256, nullptr); }
                    { pg8::Gemm g{(GAS bf16_t*)(wsb + WO_MV), GB(WS_MEMN), 256, 1024, 1024, 1024, 1024}; using E_ = pg8::EpiBf16<0, 0, 0, true>; GEMM_RUN(E_, GB(WS_MEMVT), 256, nullptr); }
                }
            PHASE_END
        }
        PHASE_BEGIN
            {
            unsigned* qctr = (unsigned*)ws + CW_ATTQ + 64 * L;
            volatile LAS int* slot = (volatile LAS int*)(MISC + 16);
            const int conv_total = (L + 1 < DEPTH) ? conv_layer_total(L + 1) : 0;
            const int n_mix = mla ? 768 : 256, u_conv = n_mix + 256, n_units = u_conv + (conv_total + 31) / 32;
            const int NQ = (mla && (G % 8 == 0)) ? 8 : 1, n_loc = mla ? 768 / NQ : 0, myq = bx % NQ;
            unsigned* qloc = qctr + 1 + myq; int loc_live = n_loc;
#define ATT_FETCH(dst) do { int f_ = -1; if (loc_live) { const unsigned v_ = __hip_atomic_fetch_add(qloc, 1u, __ATOMIC_RELAXED, __HIP_MEMORY_SCOPE_AGENT); if ((int)v_ < n_loc) f_ = myq * n_loc + (int)v_; else loc_live = 0; } \
                if (f_ < 0) f_ = (mla ? 768 : 0) + (int)__hip_atomic_fetch_add(qctr, 1u, __ATOMIC_RELAXED, __HIP_MEMORY_SCOPE_AGENT); dst = f_; } while (0)
            if (tid == 0) { int f0_; ATT_FETCH(f0_); slot[0] = f0_; }
            __syncthreads();
            for (;;) {
                const int u = __builtin_amdgcn_readfirstlane(slot[0]);
                __syncthreads();
                if (u >= n_units) break;
                int nxt = 0; if (tid == 0) ATT_FETCH(nxt);
                int tid_u = tid; asm volatile("" : "+v"(tid_u));
                const GAS bf16_t* gPROJ = GB(WS_PROJ); GAS bf16_t* gATT = GB(WS_ATT); const GAS bf16_t* gVT = GB(WS_VT);
                if (u < n_mix) {
                    if (mla) {
                        const int qq = u / n_loc, qi_ = u % n_loc, per_q = 48 / NQ; const int qb = 15 - qi_ / per_q, bh = (qi_ % per_q) * NQ + qq, b = bh / 12, h = bh % 12; const int q0 = qb * 256; const size_t rb = (size_t)b * S;
                        att::attn_unit<96, 0>(lds, GB(WS_Q) + rb * QLD + h * 96, QLD, GB(WS_KN) + rb * 768 + h * 64, 768, gPROJ + rb * PROJ_LD + 640, PROJ_LD, gVT + ((size_t)(b * 64) * 768 + h * 64) * 64, 768,
                                              gATT + rb * 1024 + h * 64, 1024, q0, 0, (q0 + 256) / 64, tid_u);
                    } else {
                        const int qb = 15 - u / 16, bk = u % 16, b = bk / 4, kvh = bk % 4; const int q0 = qb * 256; const size_t rb = (size_t)b * S;
                        att::swa_unit(lds, gPROJ + rb * PROJ_LD, gVT + ((size_t)(b * 64) * 256 + kvh * 64) * 64, gATT + rb * 1024, kvh, q0, swa_sinks + j * 12, (const GAS int*)positions + rb, tid_u);
                    }
                } else if (u < u_conv) {
                    const int v = u - n_mix, qb = v / 16, bh = v % 16, b = bh / 4, hc = bh % 4; const int q0 = qb * 256; const size_t rb = (size_t)b * S;
                    const int qc_off = mla ? 672 : 1024;
                    att::attn_unit<64, 2>(lds, gPROJ + rb * PROJ_LD + qc_off + hc * 64, PROJ_LD, GB(WS_MEMK) + (size_t)(b * NMEM) * 256 + hc * 64, 256, nullptr, 0, GB(WS_MEMVT) + ((size_t)(b * 4) * 256 + hc * 64) * 64, 256,
                                          gATT + rb * 1024 + 768 + hc * 64, 1024, q0, zz, NMEM / 64 + zz, tid_u);
                } else {
                    unsigned char* wsn = (unsigned char*)opaque_u64((unsigned long long)(ws + WS_WSET + (size_t)((L + 1) & 1) * WSET_BYTES));
                    kargp_t kp_u = (kargp_t)opaque_u64((unsigned long long)kp);
                    const int lane_u = tid_u & 63, wave_u = __builtin_amdgcn_readfirstlane(tid_u >> 6); LAS float* scr_u = (LAS float*)(lds + wave_u * 16384);
                    for (int k = 0; k < 4; ++k) { const int it = (u - u_conv) * 32 + wave_u * 4 + k; if (it < conv_total) conv_layer_item(kp_u, wsn, L + 1, it, scr_u, lane_u); }
                }
                if (tid == 0) slot[0] = nxt;
                __syncthreads();
            }
#undef ATT_FETCH
            }
        PHASE_END
        PHASE_BEGIN
            unsigned char* wsb = ws + WS_WSET + (size_t)(L & 1) * WSET_BYTES; int rot = 0;
            { pg8::Gemm g{GB(WS_ATT), (GAS bf16_t*)(wsb + WO_O), T, 1024, 1024, 1024, 1024};
              GEMM_RUN(pg8::EpiResNorm<false>, GB(WS_XB), GF(WS_SSQA), nullptr, D); }
        PHASE_END
        PHASE_BEGIN
            unsigned char* wsb = ws + WS_WSET + (size_t)(L & 1) * WSET_BYTES; int rot = 0;
            { pg8::Gemm g{GB(WS_XB), (GAS bf16_t*)(wsb + WO_UP), T, FF, 1024, 1024, 1024}; using E_ = pg8::EpiBf16<1, 0, 0>; GEMM_RUN(E_, GB(WS_ABUF), FF, nullptr); }
        PHASE_END
        PHASE_BEGIN
            unsigned char* wsb = ws + WS_WSET + (size_t)(L & 1) * WSET_BYTES; int rot = 0;
            { pg8::Gemm g{GB(WS_ABUF), (GAS bf16_t*)(wsb + WO_DN), T, 1024, FF, FF, FF};
              GEMM_RUN(pg8::EpiResNorm<true>, GB(WS_XB), GF(WS_SSQ), GF(WS_SSQA), D); }
        PHASE_END
    }
    PHASE_BEGIN
        for (int rr = gw; rr < T; rr += NGW) rms_row_out(GB(WS_XB) + (size_t)rr * D, final_norm_g, xres + (size_t)rr * D, lane);
    PHASE_END
#undef PHASE_BEGIN
#undef PHASE_END
}

extern "C" void kernel_launch(void* const* d_in, const int* in_sizes, int n_in, void* d_out, int out_size, void* d_ws, size_t ws_size, hipStream_t stream) {
    static int grid = 0;
    if (grid == 0) {
        if (n_in != 18 || out_size != T * D || ws_size < WS_END) { fprintf(stderr, "kernel_launch: unexpected shapes (n_in %d out %d ws %zu)\n", n_in, out_size, ws_size); grid = -1; return; }
        int dev = 0, cus = 0, per_cu = 0;
        if (hipGetDevice(&dev) != hipSuccess || hipDeviceGetAttribute(&cus, hipDeviceAttributeMultiprocessorCount, dev) != hipSuccess) { grid = -1; return; }
        if (hipFuncSetAttribute((const void*)trunk_fwd, hipFuncAttributeMaxDynamicSharedMemorySize, LDS_BYTES) != hipSuccess) { fprintf(stderr, "kernel_launch: hipFuncSetAttribute failed\n"); grid = -1; return; }
        if (hipOccupancyMaxActiveBlocksPerMultiprocessor(&per_cu, (const void*)trunk_fwd, NWAVES * 64, LDS_BYTES) != hipSuccess || per_cu < 1)
            fprintf(stderr, "kernel_launch: occupancy query reports %d blocks per CU\n", per_cu);
        (void)hipGetLastError();
        grid = cus;
    }
    if (grid < 0) return;
    (void)hipMemsetAsync((char*)d_ws + WS_CTL, 0, CTL_ZERO_BYTES, stream);
    Args a{};
    for (int i = 0; i < 18; ++i) a.in[i] = d_in[i];
    a.out = (float*)d_out; a.ws = (unsigned char*)d_ws;
#if MK_PER_PHASE_LAUNCH
    for (int p = 0; p < N_PHASES; ++p) { a.ph_lo = p; a.ph_hi = p + 1; hipLaunchKernelGGL(trunk_fwd, dim3(grid), dim3(NWAVES * 64), LDS_BYTES, stream, a); }
#else
    a.ph_lo = 0; a.ph_hi = N_PHASES;
    hipLaunchKernelGGL(trunk_fwd, dim3(grid), dim3(NWAVES * 64), LDS_BYTES, stream, a);
#endif
}
```

```cpp
#include <hip/hip_runtime.h>
#include <cstdio>
#include <cstdint>

#ifndef MK_PER_PHASE_LAUNCH
#define MK_PER_PHASE_LAUNCH 0
#endif

#define LAS __attribute__((address_space(3)))
#define GAS __attribute__((address_space(1)))
typedef unsigned short bf16_t;
typedef short bf16x8 __attribute__((ext_vector_type(8)));
typedef short s16x4 __attribute__((ext_vector_type(4)));
typedef float f32x2 __attribute__((ext_vector_type(2)));
typedef float f32x4 __attribute__((ext_vector_type(4)));
typedef float f32x16 __attribute__((ext_vector_type(16)));
typedef unsigned u32x2 __attribute__((ext_vector_type(2)));
typedef unsigned u32x4 __attribute__((ext_vector_type(4)));
typedef __bf16 bf16x2_t __attribute__((ext_vector_type(2)));

constexpr int NB = 4, S = 4096, T = NB * S, D = 1024, FF = 4096, NMEM = 256, DEPTH = 4;
constexpr int PROJ_LD = 1280;
constexpr int QLD = 1280;
constexpr float EPS = 1e-6f;
constexpr float LOG2E = 1.4426950408889634f;
constexpr float QS_MLA = 0.10206207261596577f * LOG2E, QS_64 = 0.125f * LOG2E;
constexpr float RESCALE_THR = 8.0f;

constexpr size_t MiB = 1u << 20;
constexpr size_t WS_CTL = 0, CTL_ZERO_BYTES = 128 * 1024;
constexpr size_t WS_COS = 1 * MiB, WS_SIN = 2 * MiB;
constexpr size_t WS_MEMN = 3 * MiB;
constexpr size_t WS_MEMK = 5 * MiB, WS_MEMVT = 5 * MiB + 512 * 1024;
constexpr size_t WS_SSQ = 6 * MiB;
constexpr size_t WS_SSQA = 9 * MiB;
constexpr size_t WS_SSQ32 = 7 * MiB;
constexpr size_t WS_WSET = 10 * MiB, WSET_BYTES = 25 * MiB;
constexpr size_t WO_IN = 0;
constexpr size_t WO_UQ = 5 * MiB / 2;
constexpr size_t WO_UK = 7 * MiB / 2, WO_UV = 4 * MiB;
constexpr size_t WO_V = 9 * MiB / 2;
constexpr size_t WO_MK = 5 * MiB, WO_MV = 11 * MiB / 2;
constexpr size_t WO_O = 6 * MiB;
constexpr size_t WO_UP = 8 * MiB;
constexpr size_t WO_DN = 16 * MiB;
constexpr size_t WS_XB = 60 * MiB;
constexpr size_t WS_ABUF = 92 * MiB;
constexpr size_t WS_PROJ = 92 * MiB;
constexpr size_t WS_Q = 132 * MiB;
constexpr size_t WS_KN = 172 * MiB;
constexpr size_t WS_VT = 196 * MiB;
constexpr size_t WS_ATT = 220 * MiB;
constexpr size_t WS_END = 252 * MiB;
constexpr int CW_ATTQ = 16384;
constexpr int CW_BAR = 4096;

constexpr int RING_BYTES = 131072;
constexpr int LDSCTL_OFF = RING_BYTES, MISC_OFF = LDSCTL_OFF + 320;
constexpr int LDS_BYTES = 147456;
constexpr int NWAVES = 8;

__device__ const float rope_inv[16] = {1.0f, 0.5623413251903491f, 0.31622776601683794f, 0.1778279410038923f, 0.1f, 0.05623413251903491f,
    0.03162277660168379f, 0.01778279410038923f, 0.01f, 0.005623413251903491f, 0.0031622776601683794f, 0.0017782794100389228f, 0.001f,
    0.0005623413251903491f, 0.00031622776601683794f, 0.00017782794100389227f};

__device__ __forceinline__ unsigned f2bf(float f) { unsigned u = __builtin_bit_cast(unsigned, f); return (u + 0x7fffu + ((u >> 16) & 1u)) >> 16; }
__device__ __forceinline__ unsigned pk2(float lo, float hi) { return f2bf(lo) | (f2bf(hi) << 16); }
__device__ __forceinline__ float bf2f(unsigned b) { return __builtin_bit_cast(float, b << 16); }
__device__ __forceinline__ unsigned cvtpk(float lo, float hi) { f32x2 v = {lo, hi}; bf16x2_t b = __builtin_convertvector(v, bf16x2_t); return __builtin_bit_cast(unsigned, b); }
#define LDS_WAIT() asm volatile("s_waitcnt lgkmcnt(0)" ::: "memory")
#define VM_WAIT() asm volatile("s_waitcnt vmcnt(0)" ::: "memory")
__device__ __forceinline__ float shfl_xor_l(float v, int o, int lane) { return __builtin_bit_cast(float, __builtin_amdgcn_ds_bpermute((lane ^ o) << 2, __builtin_bit_cast(int, v))); }
__device__ __forceinline__ float wave_sum(float v, int lane) {
#pragma unroll
    for (int o = 1; o < 64; o <<= 1) v += shfl_xor_l(v, o, lane);
    return v;
}
__device__ __forceinline__ float fadd_s(float a, float b) { float r; asm("v_add_f32 %0, %1, %2" : "=v"(r) : "v"(a), "v"(b)); return r; }
__device__ __forceinline__ int lane_id_opaque() { int l; asm volatile("v_mbcnt_lo_u32_b32 %0, -1, 0\n\tv_mbcnt_hi_u32_b32 %0, -1, %0" : "=v"(l)); return l; }

template <int FN> __device__ __forceinline__ float row_rs(const GAS float* ssq, int row) {
    if (FN == 0) { const GAS f32x4* p = (const GAS f32x4*)(ssq + (size_t)row * 16); const f32x4 a = p[0], b = p[1], c = p[2], d = p[3];
        const float s = ((a.x + a.y) + (a.z + a.w)) + ((b.x + b.y) + (b.z + b.w)) + ((c.x + c.y) + (c.z + c.w)) + ((d.x + d.y) + (d.z + d.w)); return __builtin_amdgcn_rsqf(s * (1.0f / 1024.0f) + EPS); }
    if (FN == 1) { const GAS f32x4* p = (const GAS f32x4*)(ssq + (size_t)row * 32); const f32x4 a = p[0], b = p[1], c = p[2];
        const float s = ((a.x + a.y) + (a.z + a.w)) + ((b.x + b.y) + (b.z + b.w)) + ((c.x + c.y) + (c.z + c.w)); return __builtin_amdgcn_rsqf(s * (1.0f / 384.0f) + EPS); }
    const GAS f32x4* p = (const GAS f32x4*)(ssq + (size_t)row * 32 + 12); const f32x4 a = p[0], b = p[1];
    const float s = ((a.x + a.y) + (a.z + a.w)) + ((b.x + b.y) + (b.z + b.w)); return __builtin_amdgcn_rsqf(s * (1.0f / 256.0f) + EPS);
}

namespace pg8 {
constexpr int BM = 256, BK = 64, HALF = 128, HTB = HALF * BK * 2, STAGE_BYTES = 8 * HTB, NXCD = 8, WGM = 8;
__host__ __device__ __forceinline__ int lds_byte(int r, int c) { const int st = (r >> 4) * 2 + (c >> 5), rr = r & 15, cc = c & 31, ob = rr * 64 + cc * 2; return st * 1024 + (ob ^ (((ob >> 9) & 1) << 5)); }
__host__ __device__ __forceinline__ void stage_rc(int b, int& R, int& C) { const int st = b / 1024, sb = b % 1024, swz = sb ^ (((sb >> 9) & 1) << 5); R = (st >> 1) * 16 + swz / 64; C = (st & 1) * 32 + (swz % 64) / 2; }
__host__ __device__ __forceinline__ int perm32(int rho) { const int n = rho >> 4, i = rho & 15; return 8 * (i >> 2) + 4 * n + (i & 3); }

struct Unit { int pm, pn; };
struct Gemm { const GAS bf16_t* A; const GAS bf16_t* Bt; int M, N, K, lda, ldb; };

struct StaticOrder {
    int nM, nN, nwg, G, c;
    __device__ void init(int M, int N, int G_, int c_, int rot) { nM = M / BM; nN = N / BM; nwg = nM * nN; G = G_; c = (c_ + G_ - (rot % G_)) % G_; }
    __device__ bool next(int i, Unit& u) const {
        const long L = (long)i * G + c; if (L >= nwg) return false;
        int wgid = (int)L; { const int q = nwg / NXCD, r = nwg % NXCD, xcd = wgid % NXCD, off = wgid / NXCD; wgid = (xcd < r ? xcd * (q + 1) : r * (q + 1) + (xcd - r) * q) + off; }
        const int nig = WGM * nN, gid = wgid / nig, fm = gid * WGM, gsz = (nM - fm) < WGM ? (nM - fm) : WGM;
        u.pm = fm + ((wgid % nig) % gsz); u.pn = (wgid % nig) / gsz; return true;
    }
};

__device__ __forceinline__ unsigned cvt_pk_bf16(float lo, float hi) { unsigned r; asm volatile("v_cvt_pk_bf16_f32 %0, %1, %2" : "=v"(r) : "v"(lo), "v"(hi)); return r; }

template <int ACT  , int AXIS, int FN, bool VTL = false, bool QSC = false> struct EpiBf16 {
    static constexpr bool PERM = true;
    GAS bf16_t* O; int ldc; const GAS float* ssq;
    __device__ __forceinline__ void operator()(const f32x4 (&acc)[2][2][4][2], const Unit& u, int wr, int wc, int fr, int fq) const {
        const int row0 = u.pm * BM + wr * 64 + fr; const int col0 = u.pn * BM + wc * 32 + 8 * fq;
        float cs[2][8];
        if (AXIS == 2) {
#pragma unroll
            for (int bj = 0; bj < 2; ++bj)
#pragma unroll
                for (int k = 0; k < 8; ++k) cs[bj][k] = row_rs<FN>(ssq, col0 + bj * HALF + k);
        }
#pragma unroll
        for (int ai = 0; ai < 2; ++ai)
#pragma unroll
            for (int m = 0; m < 4; ++m) { const int row = row0 + ai * HALF + m * 16;
                GAS bf16_t* rowp = VTL ? O + ((size_t)(col0 >> 6) * ldc + row) * 64 + (col0 & 63) : O + (size_t)row * ldc + col0;
                float rs = 1.f; if (AXIS == 1) rs = row_rs<FN>(ssq, row);
#pragma unroll
                for (int bj = 0; bj < 2; ++bj) { f32x4 v0 = acc[ai][bj][m][0], v1 = acc[ai][bj][m][1];
                    if (AXIS == 1) { float rq = rs; if (QSC) { const int g32 = u.pn * 8 + bj * 4 + wc; rq = (g32 < 24 || g32 >= 32) ? rs * QS_64 : rs; } v0 = v0 * rq; v1 = v1 * rq; }
                    if (AXIS == 2) {
#pragma unroll
                        for (int e = 0; e < 4; ++e) { v0[e] *= cs[bj][e]; v1[e] *= cs[bj][4 + e]; } }
                    if (ACT == 1) {
#pragma unroll
                        for (int e = 0; e < 4; ++e) { const float a = fmaxf(v0[e], 0.f), b = fmaxf(v1[e], 0.f); v0[e] = a * a; v1[e] = b * b; } }
                    u32x4 w; w.x = cvt_pk_bf16(v0[0], v0[1]); w.y = cvt_pk_bf16(v0[2], v0[3]); w.z = cvt_pk_bf16(v1[0], v1[1]); w.w = cvt_pk_bf16(v1[2], v1[3]);
                    *(GAS u32x4*)(rowp + (VTL ? (size_t)bj * 2 * ldc * 64 : (size_t)bj * HALF)) = w; } }
    }
};
template <bool SCALED> struct EpiResNorm {
    static constexpr bool PERM = true;
    GAS bf16_t* xb; GAS float* ssq; const GAS float* ssq_in; int ldc;
    __device__ __forceinline__ void operator()(const f32x4 (&acc)[2][2][4][2], const Unit& u, int wr, int wc, int fr, int fq) const {
        const int row0 = u.pm * BM + wr * 64 + fr, col0 = u.pn * BM + wc * 32 + 8 * fq; const int lane = fq * 16 + fr;
#pragma unroll
        for (int ai = 0; ai < 2; ++ai)
#pragma unroll
            for (int m = 0; m < 4; ++m) { const int row = row0 + ai * HALF + m * 16; GAS bf16_t* rowp = xb + (size_t)row * ldc + col0; float part = 0.f;
                float r2 = 1.f;
                if (SCALED) { const GAS f32x4* p = (const GAS f32x4*)(ssq_in + (size_t)row * 16); const f32x4 a = p[0], b = p[1], c = p[2], d = p[3];
                    const float s = ((a.x + a.y) + (a.z + a.w)) + ((b.x + b.y) + (b.z + b.w)) + ((c.x + c.y) + (c.z + c.w)) + ((d.x + d.y) + (d.z + d.w)); r2 = __builtin_amdgcn_rcpf(s * (1.0f / 1024.0f) + EPS); }
#pragma unroll
                for (int bj = 0; bj < 2; ++bj) { const u32x4 old = *(const GAS u32x4*)(rowp + bj * HALF); f32x4 v0 = acc[ai][bj][m][0], v1 = acc[ai][bj][m][1];
                    if (SCALED) { v0 = v0 * r2; v1 = v1 * r2; }
                    const float x0 = bf2f(old.x & 0xffffu) + v0[0], x1 = bf2f(old.x >> 16) + v0[1], x2 = bf2f(old.y & 0xffffu) + v0[2], x3 = bf2f(old.y >> 16) + v0[3];
                    const float x4 = bf2f(old.z & 0xffffu) + v1[0], x5 = bf2f(old.z >> 16) + v1[1], x6 = bf2f(old.w & 0xffffu) + v1[2], x7 = bf2f(old.w >> 16) + v1[3];
                    u32x4 w; w.x = cvt_pk_bf16(x0, x1); w.y = cvt_pk_bf16(x2, x3); w.z = cvt_pk_bf16(x4, x5); w.w = cvt_pk_bf16(x6, x7);
                    *(GAS u32x4*)(rowp + bj * HALF) = w;
                    part += ((x0 * x0 + x1 * x1) + (x2 * x2 + x3 * x3)) + ((x4 * x4 + x5 * x5) + (x6 * x6 + x7 * x7)); }
                part += shfl_xor_l(part, 16, lane); part += shfl_xor_l(part, 32, lane);
                if (fq == 0) ssq[(size_t)row * 16 + u.pn * 4 + wc] = part; }
    }
};
struct EpiRope {
    static constexpr bool PERM = false;
    GAS bf16_t* O; int ldc; const GAS float* cs; const GAS float* sn; const GAS float* ssq32;
    __device__ __forceinline__ void operator()(const f32x4 (&acc)[2][2][4][2], const Unit& u, int wr, int wc, int fr, int fq) const {
        const int row0 = u.pm * BM + wr * 64 + fr;
#pragma unroll
        for (int ai = 0; ai < 2; ++ai)
#pragma unroll
            for (int m = 0; m < 4; ++m) { const int row = row0 + ai * HALF + m * 16; const float rs = row_rs<1>(ssq32, row) * QS_MLA;
                const f32x4 c = *(const GAS f32x4*)(cs + (size_t)row * 16 + 4 * fq), s = *(const GAS f32x4*)(sn + (size_t)row * 16 + 4 * fq);
#pragma unroll
                for (int bj = 0; bj < 2; ++bj) { const int cb = u.pn * BM + bj * HALF + wc * 32; const bool rope = ((cb >> 5) % 3) == 2;
                    f32x4 v0 = acc[ai][bj][m][0] * rs, v1 = acc[ai][bj][m][1] * rs;
                    if (rope) { const f32x4 a = v0 * c - v1 * s, b = v0 * s + v1 * c; v0 = a; v1 = b; }
                    u32x2 w0, w1; w0.x = cvt_pk_bf16(v0[0], v0[1]); w0.y = cvt_pk_bf16(v0[2], v0[3]); w1.x = cvt_pk_bf16(v1[0], v1[1]); w1.y = cvt_pk_bf16(v1[2], v1[3]);
                    GAS bf16_t* p = O + (size_t)row * ldc + cb + 4 * fq; *(GAS u32x2*)p = w0; *(GAS u32x2*)(p + 16) = w1; } }
    }
};
struct EpiProjMla {
    static constexpr bool PERM = false;
    GAS bf16_t* O; int ldc; const GAS float* ssq; GAS float* ssq32; const GAS float* cs; const GAS float* sn;
    __device__ __forceinline__ void operator()(const f32x4 (&acc)[2][2][4][2], const Unit& u, int wr, int wc, int fr, int fq) const {
        const int row0 = u.pm * BM + wr * 64 + fr; const int lane = fq * 16 + fr;
#pragma unroll
        for (int ai = 0; ai < 2; ++ai)
#pragma unroll
            for (int m = 0; m < 4; ++m) { const int row = row0 + ai * HALF + m * 16; const float rs = row_rs<0>(ssq, row);
#pragma unroll
                for (int bj = 0; bj < 2; ++bj) { const int g32 = u.pn * 8 + bj * 4 + wc; const int cb = g32 * 32;
                    f32x4 v0 = acc[ai][bj][m][0] * rs, v1 = acc[ai][bj][m][1] * rs;
                    if (g32 < 20) { float part = ((v0[0] * v0[0] + v0[1] * v0[1]) + (v0[2] * v0[2] + v0[3] * v0[3])) + ((v1[0] * v1[0] + v1[1] * v1[1]) + (v1[2] * v1[2] + v1[3] * v1[3]));
                        part += shfl_xor_l(part, 16, lane); part += shfl_xor_l(part, 32, lane);
                        if (fq == 0) ssq32[(size_t)row * 32 + g32] = part; }
                    if (g32 == 20) { const f32x4 c = *(const GAS f32x4*)(cs + (size_t)row * 16 + 4 * fq), s = *(const GAS f32x4*)(sn + (size_t)row * 16 + 4 * fq);
                        const f32x4 a = v0 * c - v1 * s, b = v0 * s + v1 * c; v0 = a; v1 = b; }
                    if (g32 > 20 && g32 < 29) { v0 = v0 * QS_64; v1 = v1 * QS_64; }
                    u32x2 w0, w1; w0.x = cvt_pk_bf16(v0[0], v0[1]); w0.y = cvt_pk_bf16(v0[2], v0[3]); w1.x = cvt_pk_bf16(v1[0], v1[1]); w1.y = cvt_pk_bf16(v1[2], v1[3]);
                    GAS bf16_t* p = O + (size_t)row * ldc + cb + 4 * fq; *(GAS u32x2*)p = w0; *(GAS u32x2*)(p + 16) = w1; } }
    }
};

template <class Epi>
__device__ __forceinline__ void gemm_phase(LAS unsigned char* lds, const Gemm g, const StaticOrder& S, const Epi& E, int wave_sgpr) {
    int tid; asm volatile("v_mbcnt_lo_u32_b32 %0, -1, 0\n\tv_mbcnt_hi_u32_b32 %0, -1, %0" : "=v"(tid)); tid += wave_sgpr * 64;
    const int wid = __builtin_amdgcn_readfirstlane(tid >> 6), lane = tid & 63, wr = wid >> 2, wc = wid & 3, fr = lane & 15, fq = lane >> 4;
    const int K = g.K, nt = K / BK;
    unsigned voffA[2], voffB[2];
#pragma unroll
    for (int i = 0; i < 2; ++i) { int R, C; stage_rc(tid * 16 + i * 8192, R, C); const int Rb = Epi::PERM ? ((R & ~31) + perm32(R & 31)) : R;
        voffA[i] = (unsigned)(R * g.lda + C) * 2u; voffB[i] = (unsigned)(Rb * g.ldb + C) * 2u; }
    const size_t kstep = (size_t)(BK * 2);
    const size_t hstepA = (size_t)HALF * g.lda * 2, hstepB = (size_t)HALF * g.ldb * 2;
    const size_t tstepA = 2 * hstepA, tstepB = 2 * hstepB;
    const unsigned ldsw = (unsigned)wid * 1024u;
    const int aoff = lds_byte(wr * 64 + fr, fq * 8), boff = lds_byte(wc * 32 + fr, fq * 8);
#define PG8_SA(b, h) (((b) * 2 + (h)) * HTB)
#define PG8_SB(b, h) ((4 + (b) * 2 + (h)) * HTB)
#define PG8_STAGE(bufoff, gbase, voff) do { _Pragma("unroll") for (int _i = 0; _i < 2; ++_i) \
        __builtin_amdgcn_global_load_lds((const GAS unsigned*)((const GAS char*)(gbase) + (voff)[_i]), (LAS unsigned*)(lds + (bufoff) + ldsw + _i * 8192), 16, 0, 0); } while (0)
#define PG8_LDA(dst, b, h) do { _Pragma("unroll") for (int m = 0; m < 4; ++m) _Pragma("unroll") for (int k = 0; k < 2; ++k) dst[m][k] = *(const LAS bf16x8*)(lds + PG8_SA(b, h) + aoff + m * 2048 + k * 1024); } while (0)
#define PG8_LDB(dst, b, h) do { _Pragma("unroll") for (int n = 0; n < 2; ++n) _Pragma("unroll") for (int k = 0; k < 2; ++k) dst[n][k] = *(const LAS bf16x8*)(lds + PG8_SB(b, h) + boff + n * 2048 + k * 1024); } while (0)
#define PG8_MMA(ai, bj, At, Bt) do { __builtin_amdgcn_s_setprio(1); _Pragma("unroll") for (int m = 0; m < 4; ++m) _Pragma("unroll") for (int n = 0; n < 2; ++n) _Pragma("unroll") for (int k = 0; k < 2; ++k) \
        acc[ai][bj][m][n] = __builtin_amdgcn_mfma_f32_16x16x32_bf16(Bt[n][k], At[m][k], acc[ai][bj][m][n], 0, 0, 0); __builtin_amdgcn_s_setprio(0); } while (0)
#define PG8_WAIT_V(n) asm volatile("s_waitcnt vmcnt(" #n ")" ::: "memory")
#define PG8_WAIT_L(n) asm volatile("s_waitcnt lgkmcnt(" #n ")" ::: "memory")
#define PG8_BAR __builtin_amdgcn_s_barrier()
#define PG8_SCHED __builtin_amdgcn_sched_barrier(0)
    Unit cur, nxt; int ui = 0;
    if (!S.next(0, cur)) return;
    f32x4 acc[2][2][4][2];
#pragma unroll
    for (int a = 0; a < 2; ++a)
#pragma unroll
        for (int b = 0; b < 2; ++b)
#pragma unroll
            for (int m = 0; m < 4; ++m)
#pragma unroll
                for (int n = 0; n < 2; ++n) acc[a][b][m][n] = (f32x4){0.f, 0.f, 0.f, 0.f};
    bf16x8 At[4][2], B0[2][2], B1[2][2];
    const GAS char* cA = (const GAS char*)g.A + (size_t)cur.pm * tstepA; const GAS char* cB = (const GAS char*)g.Bt + (size_t)cur.pn * tstepB;
    PG8_STAGE(PG8_SB(0, 0), cB, voffB); PG8_STAGE(PG8_SB(0, 1), cB + hstepB, voffB); PG8_STAGE(PG8_SA(0, 0), cA, voffA); PG8_STAGE(PG8_SA(0, 1), cA + hstepA, voffA);
    if (wr == 1) PG8_BAR;
    PG8_WAIT_V(2); PG8_BAR;
    PG8_STAGE(PG8_SB(1, 0), cB + kstep, voffB); PG8_STAGE(PG8_SA(1, 0), cA + kstep, voffA); PG8_STAGE(PG8_SB(1, 1), cB + hstepB + kstep, voffB);
    PG8_WAIT_V(6); PG8_BAR;
    for (;;) {
        const bool has_next = S.next(ui + 1, nxt);
        const GAS char* nA = has_next ? (const GAS char*)g.A + (size_t)nxt.pm * tstepA : cA; const GAS char* nB = has_next ? (const GAS char*)g.Bt + (size_t)nxt.pn * tstepB : cB;
#pragma unroll 8
        for (int t = 0; t < nt; t += 2) {
            const bool last = (t == nt - 2);
            const GAS char* a1 = cA + (size_t)(t + 1) * kstep;
            const GAS char* a2 = last ? nA : cA + (size_t)(t + 2) * kstep; const GAS char* b2 = last ? nB : cB + (size_t)(t + 2) * kstep;
            const GAS char* a3 = a2 + kstep; const GAS char* b3 = b2 + kstep;
            PG8_LDB(B0, 0, 0); PG8_LDB(B1, 0, 1); PG8_SCHED; PG8_LDA(At, 0, 0); PG8_STAGE(PG8_SA(1, 1), a1 + hstepA, voffA);
            PG8_WAIT_V(8); PG8_WAIT_L(0); PG8_BAR; PG8_MMA(0, 0, At, B0); PG8_MMA(0, 1, At, B1); PG8_BAR; PG8_SCHED;
            PG8_LDA(At, 0, 1); PG8_STAGE(PG8_SB(0, 0), b2, voffB); PG8_STAGE(PG8_SB(0, 1), b2 + hstepB, voffB); PG8_STAGE(PG8_SA(0, 0), a2, voffA);
            PG8_WAIT_V(8); PG8_WAIT_L(0); PG8_BAR; PG8_MMA(1, 0, At, B0); PG8_MMA(1, 1, At, B1); PG8_BAR; PG8_SCHED;
            PG8_LDB(B0, 1, 0); PG8_LDB(B1, 1, 1); PG8_SCHED; PG8_LDA(At, 1, 0); PG8_STAGE(PG8_SA(0, 1), a2 + hstepA, voffA);
            PG8_WAIT_V(8); PG8_WAIT_L(0); PG8_BAR; PG8_MMA(0, 0, At, B0); PG8_MMA(0, 1, At, B1); PG8_BAR; PG8_SCHED;
            PG8_LDA(At, 1, 1); PG8_STAGE(PG8_SB(1, 0), b3, voffB); PG8_STAGE(PG8_SB(1, 1), b3 + hstepB, voffB); PG8_STAGE(PG8_SA(1, 0), a3, voffA);
            PG8_WAIT_V(8); PG8_WAIT_L(0); PG8_BAR; PG8_MMA(1, 0, At, B0); PG8_MMA(1, 1, At, B1); PG8_BAR; PG8_SCHED;
        }
        if (wr == 0) PG8_BAR;
        { int l2_; asm volatile("v_mbcnt_lo_u32_b32 %0, -1, 0\n\tv_mbcnt_hi_u32_b32 %0, -1, %0" : "=v"(l2_));
          E(acc, cur, wr, wc, l2_ & 15, l2_ >> 4); }
        if (!has_next) break;
#pragma unroll
        for (int a = 0; a < 2; ++a)
#pragma unroll
            for (int b = 0; b < 2; ++b)
#pragma unroll
                for (int m = 0; m < 4; ++m)
#pragma unroll
                    for (int n = 0; n < 2; ++n) acc[a][b][m][n] = (f32x4){0.f, 0.f, 0.f, 0.f};
        cur = nxt; cA = nA; cB = nB; ++ui;
        if (wr == 1) PG8_BAR;
    }
    PG8_WAIT_V(0);
    PG8_BAR;
#undef PG8_SA
#undef PG8_SB
#undef PG8_STAGE
#undef PG8_LDA
#undef PG8_LDB
#undef PG8_MMA
#undef PG8_WAIT_V
#undef PG8_WAIT_L
#undef PG8_BAR
#undef PG8_SCHED
}
}


#define XB_TMO      128
#define XB_XCNT(j)  (256  + 64 * (j))
#define XB_XSUB(j)  (1280 + 64 * (j))
#define XB_XGEN(j)  (2304 + 64 * (j))
#define XB_TOP      3328
#define XB_TOPGEN   3392
#define XCD_BAR_WORDS 3456
#define XB_SPIN_CAP (1u << 18)
__device__ __forceinline__ unsigned xb_ld(unsigned* p)              { return __hip_atomic_load(p, __ATOMIC_RELAXED, __HIP_MEMORY_SCOPE_AGENT); }
__device__ __forceinline__ unsigned xb_add(unsigned* p, unsigned v) { return __hip_atomic_fetch_add(p, v, __ATOMIC_RELAXED, __HIP_MEMORY_SCOPE_AGENT); }
__device__ __forceinline__ unsigned xb_xcc_id() { return (unsigned)__builtin_amdgcn_s_getreg((3 << 11) | 20) & 0xFu; }
#define XB_SPIN(cond, bar) do { unsigned _sp = 0; while (cond) { __builtin_amdgcn_s_sleep(1); \
    if ((++_sp & 255u) == 0u) { if (xb_ld(&(bar)[XB_TMO])) break; if (_sp > XB_SPIN_CAP) { atomicAdd(&(bar)[XB_TMO], 1u); break; } } } } while (0)
struct XcdBarrier { unsigned* bar; unsigned x; volatile LAS unsigned* st; };
__device__ __forceinline__ XcdBarrier xcd_barrier_post(unsigned* bar, volatile LAS unsigned* st) {
    XcdBarrier b; b.bar = bar; b.x = xb_xcc_id(); b.st = st;
    if (threadIdx.x == 0) (void)xb_add(&bar[XB_XCNT(b.x)], 1u);
    return b;
}
__device__ __forceinline__ void xcd_barrier_complete(unsigned* bar, unsigned x, unsigned& nloc, unsigned& nx) {
    const unsigned G = gridDim.x * gridDim.y * gridDim.z;
    unsigned sum, cnt, mine, sp = 0u;
    for (;;) {
        sum = 0u; cnt = 0u; mine = 0u;
#pragma unroll
        for (unsigned j = 0; j < 16; ++j) { const unsigned c = xb_ld(&bar[XB_XCNT(j)]); sum += c; cnt += (c > 0u) ? 1u : 0u; mine = (j == x) ? c : mine; }
        if (sum == G) break;
        __builtin_amdgcn_s_sleep(1);
        if ((++sp & 255u) == 0u) { if (xb_ld(&bar[XB_TMO])) break; if (sp > XB_SPIN_CAP) { atomicAdd(&bar[XB_TMO], 1u); break; } }
    }
    nloc = mine > 0u ? mine : 1u; nx = cnt > 0u ? cnt : 1u;
}
__device__ __forceinline__ void xcd_barrier(const XcdBarrier& b) {
    asm volatile("s_waitcnt vmcnt(0)" ::: "memory");
    __syncthreads();
    if (threadIdx.x == 0) {
        unsigned* bar = b.bar;
        __builtin_amdgcn_s_waitcnt(0);
        unsigned nloc = b.st[0], nx = b.st[1];
        if (nloc == 0u) { xcd_barrier_complete(bar, b.x, nloc, nx); b.st[0] = nloc; b.st[1] = nx; }
        const unsigned old = xb_add(&bar[XB_XSUB(b.x)], 1u);
        const unsigned gen = old / nloc;
        if (old + 1u == (gen + 1u) * nloc) {
            __builtin_amdgcn_fence(__ATOMIC_RELEASE, "agent");
            asm volatile("s_waitcnt vmcnt(0)" ::: "memory");
            const unsigned og = xb_add(&bar[XB_TOP], 1u);
            const unsigned tg = og / nx;
            if (og + 1u == (tg + 1u) * nx) xb_add(&bar[XB_TOPGEN], 1u);
            else XB_SPIN(xb_ld(&bar[XB_TOPGEN]) == tg, bar);
            __builtin_amdgcn_fence(__ATOMIC_ACQUIRE, "agent");
            asm volatile("s_waitcnt vmcnt(0)" ::: "memory");
        } else {
            XB_SPIN(xb_ld(&bar[XB_TOPGEN]) == gen, bar);
            __builtin_amdgcn_fence(__ATOMIC_ACQUIRE, "agent");
            asm volatile("s_waitcnt vmcnt(0)" ::: "memory");
        }
    }
    __syncthreads();
}

__device__ __forceinline__ void conv_item(const float* W, int ldw, int K, int srccol0, GAS bf16_t* WT, int dstrow0, LAS float* scr, int kb, int lane, const float* gain) {
    const int k0 = 64 * kb; const GAS float* Wg = (const GAS float*)W; const GAS float* gg = (const GAS float*)gain;
    const int kr = lane >> 3, nq = lane & 7;
    f32x4 v[8];
#pragma unroll
    for (int i = 0; i < 8; ++i) v[i] = *(const GAS f32x4*)(Wg + (size_t)(k0 + 8 * i + kr) * ldw + srccol0 + 4 * nq);
    if (gain) {
#pragma unroll
        for (int i = 0; i < 8; ++i) v[i] = v[i] * gg[k0 + 8 * i + kr]; }
#pragma unroll
    for (int i = 0; i < 8; ++i) { LAS float* s = scr + (8 * i + kr) * 33 + 4 * nq; s[0] = v[i].x; s[1] = v[i].y; s[2] = v[i].z; s[3] = v[i].w; }
    LDS_WAIT(); asm volatile("" ::: "memory");
    const int c = lane & 7;
#pragma unroll
    for (int j = 0; j < 4; ++j) { const int n = (lane >> 3) + 8 * j; const LAS float* s = scr + (8 * c) * 33 + n;
        u32x4 o; o.x = pk2(s[0 * 33], s[1 * 33]); o.y = pk2(s[2 * 33], s[3 * 33]); o.z = pk2(s[4 * 33], s[5 * 33]); o.w = pk2(s[6 * 33], s[7 * 33]);
        *(GAS u32x4*)(WT + (size_t)(dstrow0 + n) * K + k0 + 8 * c) = o; }
    LDS_WAIT(); asm volatile("" ::: "memory");
}
__device__ __forceinline__ bool conv_job(int& r, const float* W, int ldw, int K, int c0, int type, int ncols, GAS bf16_t* WT, int row0, LAS float* scr, int lane, const float* gain) {
    const int nblk = ncols / 32, nitems = (K / 64) * nblk;
    if (r >= nitems) { r -= nitems; return false; }
    const int kb = r / nblk, n0 = 32 * (r % nblk);
    const int src = type == 0 ? c0 + n0 : c0 + (n0 >> 6) * 128 + (n0 & 63);
    conv_item(W, ldw, K, src, WT, row0 + n0, scr, kb, lane, gain);
    return true;
}
__device__ __forceinline__ void rms_row_bf16(const float* xrow, const float* g, GAS bf16_t* orow, int lane) {
    const GAS f32x4* xr = (const GAS f32x4*)xrow + lane; const GAS f32x4* gr = (const GAS f32x4*)g + lane;
    f32x4 v[4]; float s = 0.f;
#pragma unroll
    for (int j = 0; j < 4; ++j) { v[j] = xr[64 * j]; s += (v[j].x * v[j].x + v[j].y * v[j].y) + (v[j].z * v[j].z + v[j].w * v[j].w); }
    const float rs = 1.0f / sqrtf(wave_sum(s, lane) * (1.0f / 1024.0f) + EPS);
    GAS unsigned long long* o8 = (GAS unsigned long long*)orow + lane;
#pragma unroll
    for (int j = 0; j < 4; ++j) { const f32x4 gv = gr[64 * j]; const f32x4 y = v[j] * rs * gv;
        o8[64 * j] = (unsigned long long)pk2(y.x, y.y) | ((unsigned long long)pk2(y.z, y.w) << 32); }
}
__device__ __forceinline__ void copy_row_bf16_ssq(const float* xrow, GAS bf16_t* orow, GAS float* ssq16, int lane) {
    const GAS f32x4* xr = (const GAS f32x4*)xrow + lane;
    float s = 0.f;
    GAS unsigned long long* o8 = (GAS unsigned long long*)orow + lane;
#pragma unroll
    for (int j = 0; j < 4; ++j) { const f32x4 v = xr[64 * j]; const unsigned a = pk2(v.x, v.y), b = pk2(v.z, v.w);
        o8[64 * j] = (unsigned long long)a | ((unsigned long long)b << 32);
        const float r0 = bf2f(a & 0xffffu), r1 = bf2f(a >> 16), r2 = bf2f(b & 0xffffu), r3 = bf2f(b >> 16); s += (r0 * r0 + r1 * r1) + (r2 * r2 + r3 * r3); }
    s = wave_sum(s, lane);
    if (lane < 16) ssq16[lane] = lane == 0 ? s : 0.f;
}
__device__ __forceinline__ void rms_row_out(const GAS bf16_t* xrow, const float* g, float* orow, int lane) {
    const GAS u32x4* xr = (const GAS u32x4*)xrow + lane; const GAS f32x4* gr = (const GAS f32x4*)g; GAS f32x4* o = (GAS f32x4*)orow;
    float v[2][8]; float s = 0.f;
#pragma unroll
    for (int j = 0; j < 2; ++j) { const u32x4 w = xr[64 * j];
#pragma unroll
        for (int e = 0; e < 4; ++e) { v[j][2 * e] = bf2f(w[e] & 0xffffu); v[j][2 * e + 1] = bf2f(w[e] >> 16); s += v[j][2 * e] * v[j][2 * e] + v[j][2 * e + 1] * v[j][2 * e + 1]; } }
    const float rs = 1.0f / sqrtf(wave_sum(s, lane) * (1.0f / 1024.0f) + EPS);
#pragma unroll
    for (int j = 0; j < 2; ++j) { const int i4 = 128 * j + 2 * lane; const f32x4 g0 = gr[i4], g1 = gr[i4 + 1];
        o[i4] = (f32x4){v[j][0] * rs * g0.x, v[j][1] * rs * g0.y, v[j][2] * rs * g0.z, v[j][3] * rs * g0.w};
        o[i4 + 1] = (f32x4){v[j][4] * rs * g1.x, v[j][5] * rs * g1.y, v[j][6] * rs * g1.z, v[j][7] * rs * g1.w}; }
}
__device__ __forceinline__ void sincos_acc(float ang, float& sn, float& cs) {
    const double a = (double)ang; const double kd = __builtin_rint(a * 0.6366197723675814); const int k = (int)kd;
    const double r = (a - kd * 1.5707963267948966) - kd * 6.123233995736766e-17, r2 = r * r;
    const double sp = r * (1.0 + r2 * (-1.0 / 6 + r2 * (1.0 / 120 + r2 * (-1.0 / 5040 + r2 * (1.0 / 362880 + r2 * (-1.0 / 39916800))))));
    const double cp = 1.0 + r2 * (-0.5 + r2 * (1.0 / 24 + r2 * (-1.0 / 720 + r2 * (1.0 / 40320 + r2 * (-1.0 / 3628800 + r2 * (1.0 / 479001600))))));
    const int q = k & 3;
    const double s_ = (q == 0) ? sp : (q == 1) ? cp : (q == 2) ? -sp : -cp;
    const double c_ = (q == 0) ? cp : (q == 1) ? -sp : (q == 2) ? -cp : sp;
    sn = (float)s_; cs = (float)c_;
}

namespace att {
constexpr int KROW = 208, VROW = 144, KT_BYTES = 64 * KROW, VT_BYTES = 64 * VROW, BUF_BYTES = KT_BYTES + VT_BYTES;
struct Stage { u32x4 k1, k2, v; };
#define ATT_RD(F, BASE, OFF) asm volatile("ds_read_b128 %0, %1 offset:" #OFF : "=v"(F) : "v"(BASE))
#define ATT_WT(N, F) asm volatile("s_waitcnt lgkmcnt(" #N ")" : "+v"(F))
__device__ __forceinline__ void att_mseg_sp(unsigned kb, unsigned vb, const bf16x8 (&qf)[6], const f32x16& negm, f32x16& s0, f32x16& s1, const u32x4& w0, const u32x4& w1, const u32x4& w2, const u32x4& w3, f32x16& o0, f32x16& o1) {
    bf16x8 f0, f1, f2, f3, f4, f5;
    const bf16x8 p0 = __builtin_bit_cast(bf16x8, w0), p1 = __builtin_bit_cast(bf16x8, w1), p2 = __builtin_bit_cast(bf16x8, w2), p3 = __builtin_bit_cast(bf16x8, w3);
    ATT_RD(f0, kb, 0); ATT_RD(f1, kb, 6656); ATT_RD(f2, vb, 0); ATT_RD(f3, vb, 4608); ATT_RD(f4, kb, 32);
    ATT_WT(4, f0); s0 = __builtin_amdgcn_mfma_f32_32x32x16_bf16(f0, qf[0], negm, 0, 0, 0); ATT_RD(f5, kb, 6688);
    ATT_WT(4, f1); s1 = __builtin_amdgcn_mfma_f32_32x32x16_bf16(f1, qf[0], negm, 0, 0, 0); ATT_RD(f0, vb, 32);
    ATT_WT(4, f2); o0 = __builtin_amdgcn_mfma_f32_32x32x16_bf16(f2, p0, o0, 0, 0, 0); ATT_RD(f1, vb, 4640);
    ATT_WT(4, f3); o1 = __builtin_amdgcn_mfma_f32_32x32x16_bf16(f3, p0, o1, 0, 0, 0); ATT_RD(f2, kb, 64);
    ATT_WT(4, f4); s0 = __builtin_amdgcn_mfma_f32_32x32x16_bf16(f4, qf[1], s0, 0, 0, 0); ATT_RD(f3, kb, 6720);
    ATT_WT(4, f5); s1 = __builtin_amdgcn_mfma_f32_32x32x16_bf16(f5, qf[1], s1, 0, 0, 0); ATT_RD(f4, vb, 64);
    ATT_WT(4, f0); o0 = __builtin_amdgcn_mfma_f32_32x32x16_bf16(f0, p1, o0, 0, 0, 0); ATT_RD(f5, vb, 4672);
    ATT_WT(4, f1); o1 = __builtin_amdgcn_mfma_f32_32x32x16_bf16(f1, p1, o1, 0, 0, 0); ATT_RD(f0, kb, 96);
    ATT_WT(4, f2); s0 = __builtin_amdgcn_mfma_f32_32x32x16_bf16(f2, qf[2], s0, 0, 0, 0); ATT_RD(f1, kb, 6752);
    ATT_WT(4, f3); s1 = __builtin_amdgcn_mfma_f32_32x32x16_bf16(f3, qf[2], s1, 0, 0, 0); ATT_RD(f2, vb, 96);
    ATT_WT(4, f4); o0 = __builtin_amdgcn_mfma_f32_32x32x16_bf16(f4, p2, o0, 0, 0, 0); ATT_RD(f3, vb, 4704);
    ATT_WT(4, f5); o1 = __builtin_amdgcn_mfma_f32_32x32x16_bf16(f5, p2, o1, 0, 0, 0); ATT_RD(f4, kb, 128);
    ATT_WT(4, f0); s0 = __builtin_amdgcn_mfma_f32_32x32x16_bf16(f0, qf[3], s0, 0, 0, 0); ATT_RD(f5, kb, 6784);
    ATT_WT(4, f1); s1 = __builtin_amdgcn_mfma_f32_32x32x16_bf16(f1, qf[3], s1, 0, 0, 0); ATT_RD(f0, kb, 160);
    ATT_WT(4, f2); o0 = __builtin_amdgcn_mfma_f32_32x32x16_bf16(f2, p3, o0, 0, 0, 0); ATT_RD(f1, kb, 6816);
    ATT_WT(4, f3); o1 = __builtin_amdgcn_mfma_f32_32x32x16_bf16(f3, p3, o1, 0, 0, 0);
    ATT_WT(3, f4); s0 = __builtin_amdgcn_mfma_f32_32x32x16_bf16(f4, qf[4], s0, 0, 0, 0);
    ATT_WT(2, f5); s1 = __builtin_amdgcn_mfma_f32_32x32x16_bf16(f5, qf[4], s1, 0, 0, 0);
    ATT_WT(1, f0); s0 = __builtin_amdgcn_mfma_f32_32x32x16_bf16(f0, qf[5], s0, 0, 0, 0);
    ATT_WT(0, f1); s1 = __builtin_amdgcn_mfma_f32_32x32x16_bf16(f1, qf[5], s1, 0, 0, 0);
}
__device__ __forceinline__ void att_mseg_s(unsigned kb, const bf16x8 (&qf)[6], const f32x16& negm, f32x16& s0, f32x16& s1) {
    bf16x8 f0, f1, f2, f3, f4, f5;
    ATT_RD(f0, kb, 0); ATT_RD(f1, kb, 6656); ATT_RD(f2, kb, 32); ATT_RD(f3, kb, 6688); ATT_RD(f4, kb, 64);
    ATT_WT(4, f0); s0 = __builtin_amdgcn_mfma_f32_32x32x16_bf16(f0, qf[0], negm, 0, 0, 0); ATT_RD(f5, kb, 6720);
    ATT_WT(4, f1); s1 = __builtin_amdgcn_mfma_f32_32x32x16_bf16(f1, qf[0], negm, 0, 0, 0); ATT_RD(f0, kb, 96);
    ATT_WT(4, f2); s0 = __builtin_amdgcn_mfma_f32_32x32x16_bf16(f2, qf[1], s0, 0, 0, 0); ATT_RD(f1, kb, 6752);
    ATT_WT(4, f3); s1 = __builtin_amdgcn_mfma_f32_32x32x16_bf16(f3, qf[1], s1, 0, 0, 0); ATT_RD(f2, kb, 128);
    ATT_WT(4, f4); s0 = __builtin_amdgcn_mfma_f32_32x32x16_bf16(f4, qf[2], s0, 0, 0, 0); ATT_RD(f3, kb, 6784);
    ATT_WT(4, f5); s1 = __builtin_amdgcn_mfma_f32_32x32x16_bf16(f5, qf[2], s1, 0, 0, 0); ATT_RD(f4, kb, 160);
    ATT_WT(4, f0); s0 = __builtin_amdgcn_mfma_f32_32x32x16_bf16(f0, qf[3], s0, 0, 0, 0); ATT_RD(f5, kb, 6816);
    ATT_WT(4, f1); s1 = __builtin_amdgcn_mfma_f32_32x32x16_bf16(f1, qf[3], s1, 0, 0, 0);
    ATT_WT(3, f2); s0 = __builtin_amdgcn_mfma_f32_32x32x16_bf16(f2, qf[4], s0, 0, 0, 0);
    ATT_WT(2, f3); s1 = __builtin_amdgcn_mfma_f32_32x32x16_bf16(f3, qf[4], s1, 0, 0, 0);
    ATT_WT(1, f4); s0 = __builtin_amdgcn_mfma_f32_32x32x16_bf16(f4, qf[5], s0, 0, 0, 0);
    ATT_WT(0, f5); s1 = __builtin_amdgcn_mfma_f32_32x32x16_bf16(f5, qf[5], s1, 0, 0, 0);
}
__device__ __forceinline__ void att_mseg_sp(unsigned kb, unsigned vb, const bf16x8 (&qf)[4], const f32x16& negm, f32x16& s0, f32x16& s1, const u32x4& w0, const u32x4& w1, const u32x4& w2, const u32x4& w3, f32x16& o0, f32x16& o1) {
    bf16x8 f0, f1, f2, f3, f4, f5;
    const bf16x8 p0 = __builtin_bit_cast(bf16x8, w0), p1 = __builtin_bit_cast(bf16x8, w1), p2 = __builtin_bit_cast(bf16x8, w2), p3 = __builtin_bit_cast(bf16x8, w3);
    ATT_RD(f0, kb, 0); ATT_RD(f1, kb, 6656); ATT_RD(f2, vb, 0); ATT_RD(f3, vb, 4608); ATT_RD(f4, kb, 32);
    ATT_WT(4, f0); s0 = __builtin_amdgcn_mfma_f32_32x32x16_bf16(f0, qf[0], negm, 0, 0, 0); ATT_RD(f5, kb, 6688);
    ATT_WT(4, f1); s1 = __builtin_amdgcn_mfma_f32_32x32x16_bf16(f1, qf[0], negm, 0, 0, 0); ATT_RD(f0, vb, 32);
    ATT_WT(4, f2); o0 = __builtin_amdgcn_mfma_f32_32x32x16_bf16(f2, p0, o0, 0, 0, 0); ATT_RD(f1, vb, 4640);
    ATT_WT(4, f3); o1 = __builtin_amdgcn_mfma_f32_32x32x16_bf16(f3, p0, o1, 0, 0, 0); ATT_RD(f2, kb, 64);
    ATT_WT(4, f4); s0 = __builtin_amdgcn_mfma_f32_32x32x16_bf16(f4, qf[1], s0, 0, 0, 0); ATT_RD(f3, kb, 6720);
    ATT_WT(4, f5); s1 = __builtin_amdgcn_mfma_f32_32x32x16_bf16(f5, qf[1], s1, 0, 0, 0); ATT_RD(f4, vb, 64);
    ATT_WT(4, f0); o0 = __builtin_amdgcn_mfma_f32_32x32x16_bf16(f0, p1, o0, 0, 0, 0); ATT_RD(f5, vb, 4672);
    ATT_WT(4, f1); o1 = __builtin_amdgcn_mfma_f32_32x32x16_bf16(f1, p1, o1, 0, 0, 0); ATT_RD(f0, kb, 96);
    ATT_WT(4, f2); s0 = __builtin_amdgcn_mfma_f32_32x32x16_bf16(f2, qf[2], s0, 0, 0, 0); ATT_RD(f1, kb, 6752);
    ATT_WT(4, f3); s1 = __builtin_amdgcn_mfma_f32_32x32x16_bf16(f3, qf[2], s1, 0, 0, 0); ATT_RD(f2, vb, 96);
    ATT_WT(4, f4); o0 = __builtin_amdgcn_mfma_f32_32x32x16_bf16(f4, p2, o0, 0, 0, 0); ATT_RD(f3, vb, 4704);
    ATT_WT(4, f5); o1 = __builtin_amdgcn_mfma_f32_32x32x16_bf16(f5, p2, o1, 0, 0, 0);
    ATT_WT(3, f0); s0 = __builtin_amdgcn_mfma_f32_32x32x16_bf16(f0, qf[3], s0, 0, 0, 0);
    ATT_WT(2, f1); s1 = __builtin_amdgcn_mfma_f32_32x32x16_bf16(f1, qf[3], s1, 0, 0, 0);
    ATT_WT(1, f2); o0 = __builtin_amdgcn_mfma_f32_32x32x16_bf16(f2, p3, o0, 0, 0, 0);
    ATT_WT(0, f3); o1 = __builtin_amdgcn_mfma_f32_32x32x16_bf16(f3, p3, o1, 0, 0, 0);
}
__device__ __forceinline__ void att_mseg_s(unsigned kb, const bf16x8 (&qf)[4], const f32x16& negm, f32x16& s0, f32x16& s1) {
    bf16x8 f0, f1, f2, f3, f4, f5;
    ATT_RD(f0, kb, 0); ATT_RD(f1, kb, 6656); ATT_RD(f2, kb, 32); ATT_RD(f3, kb, 6688); ATT_RD(f4, kb, 64);
    ATT_WT(4, f0); s0 = __builtin_amdgcn_mfma_f32_32x32x16_bf16(f0, qf[0], negm, 0, 0, 0); ATT_RD(f5, kb, 6720);
    ATT_WT(4, f1); s1 = __builtin_amdgcn_mfma_f32_32x32x16_bf16(f1, qf[0], negm, 0, 0, 0); ATT_RD(f0, kb, 96);
    ATT_WT(4, f2); s0 = __builtin_amdgcn_mfma_f32_32x32x16_bf16(f2, qf[1], s0, 0, 0, 0); ATT_RD(f1, kb, 6752);
    ATT_WT(4, f3); s1 = __builtin_amdgcn_mfma_f32_32x32x16_bf16(f3, qf[1], s1, 0, 0, 0);
    ATT_WT(3, f4); s0 = __builtin_amdgcn_mfma_f32_32x32x16_bf16(f4, qf[2], s0, 0, 0, 0);
    ATT_WT(2, f5); s1 = __builtin_amdgcn_mfma_f32_32x32x16_bf16(f5, qf[2], s1, 0, 0, 0);
    ATT_WT(1, f0); s0 = __builtin_amdgcn_mfma_f32_32x32x16_bf16(f0, qf[3], s0, 0, 0, 0);
    ATT_WT(0, f1); s1 = __builtin_amdgcn_mfma_f32_32x32x16_bf16(f1, qf[3], s1, 0, 0, 0);
}
__device__ __forceinline__ void att_mseg_p(unsigned vb, const u32x4& w0, const u32x4& w1, const u32x4& w2, const u32x4& w3, f32x16& o0, f32x16& o1) {
    bf16x8 f0, f1, f2, f3, f4, f5;
    const bf16x8 p0 = __builtin_bit_cast(bf16x8, w0), p1 = __builtin_bit_cast(bf16x8, w1), p2 = __builtin_bit_cast(bf16x8, w2), p3 = __builtin_bit_cast(bf16x8, w3);
    ATT_RD(f0, vb, 0); ATT_RD(f1, vb, 4608); ATT_RD(f2, vb, 32); ATT_RD(f3, vb, 4640); ATT_RD(f4, vb, 64);
    ATT_WT(4, f0); o0 = __builtin_amdgcn_mfma_f32_32x32x16_bf16(f0, p0, o0, 0, 0, 0); ATT_RD(f5, vb, 4672);
    ATT_WT(4, f1); o1 = __builtin_amdgcn_mfma_f32_32x32x16_bf16(f1, p0, o1, 0, 0, 0); ATT_RD(f0, vb, 96);
    ATT_WT(4, f2); o0 = __builtin_amdgcn_mfma_f32_32x32x16_bf16(f2, p1, o0, 0, 0, 0); ATT_RD(f1, vb, 4704);
    ATT_WT(4, f3); o1 = __builtin_amdgcn_mfma_f32_32x32x16_bf16(f3, p1, o1, 0, 0, 0);
    ATT_WT(3, f4); o0 = __builtin_amdgcn_mfma_f32_32x32x16_bf16(f4, p2, o0, 0, 0, 0);
    ATT_WT(2, f5); o1 = __builtin_amdgcn_mfma_f32_32x32x16_bf16(f5, p2, o1, 0, 0, 0);
    ATT_WT(1, f0); o0 = __builtin_amdgcn_mfma_f32_32x32x16_bf16(f0, p3, o0, 0, 0, 0);
    ATT_WT(0, f1); o1 = __builtin_amdgcn_mfma_f32_32x32x16_bf16(f1, p3, o1, 0, 0, 0);
}
#undef ATT_RD
#undef ATT_WT
template <int MODE>
__device__ __forceinline__ void att_softmax(int t, bool first, f32x16& s0, f32x16& s1, f32x16& o0, f32x16& o1, float& lsum, f32x16& negm, u32x4& w0, u32x4& w1, u32x4& w2, u32x4& w3,
                                            int qw) {
    const int key0 = t * 64;
    if (MODE == 0 && key0 + 63 > qw) {
        const int l_ = lane_id_opaque(), qi = qw + (l_ & 31), hh = l_ >> 5;
#pragma unroll
        for (int i = 0; i < 16; ++i) { const int key = key0 + (i & 3) + 8 * (i >> 2) + 4 * hh; if (key > qi) s0[i] = -INFINITY; if (key + 32 > qi) s1[i] = -INFINITY; }
    }
    float a = fmaxf(fmaxf(s0[0], s0[1]), s1[0]), b = fmaxf(fmaxf(s0[2], s0[3]), s1[1]);
    a = fmaxf(fmaxf(a, s1[2]), s1[3]);
#pragma unroll
    for (int i = 4; i < 16; i += 4) { a = fmaxf(fmaxf(a, s0[i]), s0[i + 1]); b = fmaxf(fmaxf(b, s0[i + 2]), s0[i + 3]); a = fmaxf(fmaxf(a, s1[i]), s1[i + 1]); b = fmaxf(fmaxf(b, s1[i + 2]), s1[i + 3]); }
    float smax = fmaxf(a, b);
    { const auto rr = __builtin_amdgcn_permlane32_swap(__builtin_bit_cast(unsigned, smax), __builtin_bit_cast(unsigned, smax), false, false);
      smax = fmaxf(__builtin_bit_cast(float, (unsigned)rr[0]), __builtin_bit_cast(float, (unsigned)rr[1])); }
    if (first || (__builtin_amdgcn_ballot_w64(smax > RESCALE_THR) != 0ull)) {
        const float d = first ? smax : fmaxf(smax, 0.f);
#pragma unroll
        for (int i = 0; i < 16; ++i) { s0[i] -= d; s1[i] -= d; negm[i] -= d; }
        if (!first) { const float alpha = __builtin_amdgcn_exp2f(-d);
#pragma unroll
            for (int i = 0; i < 16; ++i) { o0[i] *= alpha; o1[i] *= alpha; } lsum *= alpha; }
    }
#pragma unroll
    for (int i = 0; i < 16; ++i) { s0[i] = __builtin_amdgcn_exp2f(s0[i]); s1[i] = __builtin_amdgcn_exp2f(s1[i]); }
    __builtin_amdgcn_sched_barrier(0);
    w0[0] = cvtpk(s0[0], s0[1]); w0[1] = cvtpk(s0[2], s0[3]); w0[2] = cvtpk(s0[4], s0[5]); w0[3] = cvtpk(s0[6], s0[7]);
    w1[0] = cvtpk(s0[8], s0[9]); w1[1] = cvtpk(s0[10], s0[11]); w1[2] = cvtpk(s0[12], s0[13]); w1[3] = cvtpk(s0[14], s0[15]);
    w2[0] = cvtpk(s1[0], s1[1]); w2[1] = cvtpk(s1[2], s1[3]); w2[2] = cvtpk(s1[4], s1[5]); w2[3] = cvtpk(s1[6], s1[7]);
    w3[0] = cvtpk(s1[8], s1[9]); w3[1] = cvtpk(s1[10], s1[11]); w3[2] = cvtpk(s1[12], s1[13]); w3[3] = cvtpk(s1[14], s1[15]);
    float ls_a = fadd_s(s0[0], s0[1]), ls_b = fadd_s(s0[2], s0[3]), ls_c = fadd_s(s1[0], s1[1]), ls_d = fadd_s(s1[2], s1[3]);
#pragma unroll
    for (int i = 4; i < 16; i += 4) { ls_a = fadd_s(ls_a, fadd_s(s0[i], s0[i + 1])); ls_b = fadd_s(ls_b, fadd_s(s0[i + 2], s0[i + 3])); ls_c = fadd_s(ls_c, fadd_s(s1[i], s1[i + 1])); ls_d = fadd_s(ls_d, fadd_s(s1[i + 2], s1[i + 3])); }
    ls_a = fadd_s(ls_a, ls_c); ls_b = fadd_s(ls_b, ls_d);
    lsum += ls_a + ls_b;
}
template <int DK, int MODE>
__device__ __forceinline__ void attn_unit(LAS unsigned char* lds, const GAS bf16_t* Qp, int ldq, const GAS bf16_t* K1, int ldk1, const GAS bf16_t* K2, int ldk2, const GAS bf16_t* Vt, int ldv,
                                          GAS bf16_t* O, int ldo, int q0, int t_lo, int t_hi, int tid) {
    const int wave = __builtin_amdgcn_readfirstlane(tid >> 6), lane = tid & 63, r = lane & 31, hh = lane >> 5;
    const int qw = q0 + 32 * wave, qi = qw + r;
    const bool late = wave >= 4;
    bf16x8 qf[DK / 16];
#pragma unroll
    for (int s = 0; s < DK / 16; ++s) qf[s] = *(const GAS bf16x8*)(Qp + (size_t)qi * ldq + 16 * s + 8 * hh);
    f32x16 o0, o1, negm, s0, s1; u32x4 w0, w1, w2, w3; float lsum = 0.f;
#pragma unroll
    for (int i = 0; i < 16; ++i) { o0[i] = 0.f; o1[i] = 0.f; negm[i] = 0.f; s0[i] = 0.f; s1[i] = 0.f; }
    w0 = (u32x4){0u, 0u, 0u, 0u}; w1 = w0; w2 = w0; w3 = w0;
    const int sk_row = tid >> 3, sk_ch = tid & 7;
    const unsigned vk1 = (unsigned)(sk_row * ldk1 + sk_ch * 8) * 2u, vk2 = (unsigned)(((tid >> 2) & 63) * ldk2 + (tid & 3) * 8) * 2u, vv = (unsigned)(sk_row * 64 + sk_ch * 8) * 2u;
    const size_t vts = (size_t)ldv * 64;
    const int kw_off = sk_row * KROW + sk_ch * 16, k2w_off = ((tid >> 2) & 63) * KROW + 128 + (tid & 3) * 16, vw_off = KT_BYTES + sk_row * VROW + (sk_ch >> 1) * 32 + (sk_ch & 1) * 8;
    const bool st_k2 = wave < 4;
    Stage A, B; A.k2 = (u32x4){0u, 0u, 0u, 0u}; B.k2 = A.k2;
#define ATT_LOAD1(R, tile) do { const int tl_ = (tile) < t_hi ? (tile) : t_hi - 1; const size_t k_ = (size_t)tl_ * 64; R.k1 = *(const GAS u32x4*)((const GAS char*)(K1 + k_ * ldk1) + vk1); \
        if (DK == 96) R.k2 = *(const GAS u32x4*)((const GAS char*)(K2 + k_ * ldk2) + vk2); R.v = *(const GAS u32x4*)((const GAS char*)(Vt + (size_t)tl_ * vts) + vv); } while (0)
#define ATT_STORE1(R, off) do { LAS unsigned char* b_ = lds + (off); *(LAS u32x4*)(b_ + kw_off) = R.k1; if (DK == 96) { if (st_k2) *(LAS u32x4*)(b_ + k2w_off) = R.k2; } \
        *(LAS u32x2*)(b_ + vw_off) = (u32x2){R.v.x, R.v.y}; *(LAS u32x2*)(b_ + vw_off + 16) = (u32x2){R.v.z, R.v.w}; } while (0)
#define ATT_NEED(t_) ((MODE == 2) || ((t_) * 64 <= qw + 31))
#define ATT_BUFO(t_) (((t_) & 3) * BUF_BYTES)
#define ATT_BAR  do { __builtin_amdgcn_sched_barrier(0); asm volatile("" ::: "memory"); __builtin_amdgcn_s_barrier(); asm volatile("" ::: "memory"); __builtin_amdgcn_sched_barrier(0); } while (0)
#define ATT_BARW do { __builtin_amdgcn_sched_barrier(0); asm volatile("s_waitcnt lgkmcnt(0)" ::: "memory"); __builtin_amdgcn_s_barrier(); asm volatile("" ::: "memory"); __builtin_amdgcn_sched_barrier(0); } while (0)
#define ATT_MSEG(u_) do { const unsigned kb_ = kfrag_a + ATT_BUFO(u_); const unsigned vb_ = vfrag_a + ATT_BUFO((u_) - 1); \
        if (ATT_NEED(u_)) att_mseg_sp(kb_, vb_, qf, negm, s0, s1, w0, w1, w2, w3, o0, o1); \
        else if (ATT_NEED((u_) - 1)) att_mseg_p(vb_, w0, w1, w2, w3, o0, o1); } while (0)
    const unsigned kfrag_a = (unsigned)(size_t)lds + (unsigned)(r * KROW + hh * 16), vfrag_a = (unsigned)(size_t)lds + (unsigned)(KT_BYTES + r * VROW + hh * 16);
    ATT_LOAD1(A, t_lo); ATT_LOAD1(B, t_lo + 1);
    ATT_STORE1(A, ATT_BUFO(t_lo)); ATT_STORE1(B, ATT_BUFO(t_lo + 1));
    ATT_LOAD1(A, t_lo + 2);
    ATT_BARW;
    if (late) ATT_BAR;
    if (ATT_NEED(t_lo)) att_mseg_s(kfrag_a + ATT_BUFO(t_lo), qf, negm, s0, s1);
    ATT_BAR;
    for (int t = t_lo; ; t += 2) {
        if (ATT_NEED(t)) att_softmax<MODE>(t, t == t_lo, s0, s1, o0, o1, lsum, negm, w0, w1, w2, w3, qw);
        __builtin_amdgcn_sched_barrier(0);
        if (t + 2 < t_hi) ATT_STORE1(A, ATT_BUFO(t + 2));
        ATT_LOAD1(A, t + 3);
        ATT_BARW;
        ATT_MSEG(t + 1);
        ATT_BAR;
        if (ATT_NEED(t + 1)) att_softmax<MODE>(t + 1, false, s0, s1, o0, o1, lsum, negm, w0, w1, w2, w3, qw);
        __builtin_amdgcn_sched_barrier(0);
        if (t + 3 < t_hi) ATT_STORE1(A, ATT_BUFO(t + 3));
        ATT_LOAD1(A, t + 4);
        ATT_BARW;
        if (t + 2 >= t_hi) break;
        ATT_MSEG(t + 2);
        ATT_BAR;
    }
    if (ATT_NEED(t_hi - 1)) att_mseg_p(vfrag_a + ATT_BUFO(t_hi - 1), w0, w1, w2, w3, o0, o1);
    if (!late) ATT_BAR;
#undef ATT_LOAD1
#undef ATT_STORE1
#undef ATT_NEED
#undef ATT_BUFO
#undef ATT_BAR
#undef ATT_BARW
#undef ATT_MSEG
    float inv;
    { const auto rr = __builtin_amdgcn_permlane32_swap(__builtin_bit_cast(unsigned, lsum), __builtin_bit_cast(unsigned, lsum), false, false);
      inv = 1.0f / (__builtin_bit_cast(float, (unsigned)rr[0]) + __builtin_bit_cast(float, (unsigned)rr[1])); }
    const int le_ = lane_id_opaque();
    GAS bf16_t* op = O + (size_t)(qw + (le_ & 31)) * ldo + 4 * (le_ >> 5);
#pragma unroll
    for (int g = 0; g < 4; ++g) {
        u32x2 w0_, w1_;
        w0_.x = cvtpk(o0[4 * g + 0] * inv, o0[4 * g + 1] * inv); w0_.y = cvtpk(o0[4 * g + 2] * inv, o0[4 * g + 3] * inv);
        w1_.x = cvtpk(o1[4 * g + 0] * inv, o1[4 * g + 1] * inv); w1_.y = cvtpk(o1[4 * g + 2] * inv, o1[4 * g + 3] * inv);
        *(GAS u32x2*)(op + 8 * g) = w0_; *(GAS u32x2*)(op + 32 + 8 * g) = w1_;
    }
}
constexpr int SW_ROW = 144, SW_KT = 64 * SW_ROW, SW_V_OFF = 6 * SW_KT, SW_P_OFF = 12 * SW_KT, SW_BYTES = SW_P_OFF + 6 * 256;
__device__ __forceinline__ void swa_unit(LAS unsigned char* lds, const GAS bf16_t* proj, const GAS bf16_t* Vt, GAS bf16_t* O, int kvh, int q0, const float* sinks, const GAS int* pos, int tid) {
    const int wave = __builtin_amdgcn_readfirstlane(tid >> 6), lane = tid & 63, r = lane & 31, hh = lane >> 5;
    const int qw = q0 + 32 * wave, qi = qw + r;
    const int tl = q0 >= 128 ? (q0 - 128) >> 6 : 0, th = (q0 + 256) >> 6, nt = th - tl;
    {
        const int sk_row = tid >> 3, sk_ch = tid & 7;
        const GAS bf16_t* gk = proj + (size_t)(tl * 64 + sk_row) * PROJ_LD + 768 + kvh * 64 + sk_ch * 8;
        const GAS bf16_t* gv = Vt + ((size_t)tl * 256 + sk_row) * 64 + sk_ch * 8;
        LAS unsigned char* kw = lds + sk_row * SW_ROW + sk_ch * 16; LAS unsigned char* vw = lds + SW_V_OFF + sk_row * SW_ROW + (sk_ch >> 1) * 32 + (sk_ch & 1) * 8;
#pragma unroll
        for (int bt = 0; bt < 2; ++bt) {
            u32x4 k0, k1, k2, v0, v1, v2; const int i0 = 3 * bt;
            k0 = *(const GAS u32x4*)(gk + (size_t)(i0 + 0) * 64 * PROJ_LD); v0 = *(const GAS u32x4*)(gv + (size_t)(i0 + 0) * 256 * 64);
            k1 = *(const GAS u32x4*)(gk + (size_t)(i0 + 1) * 64 * PROJ_LD); v1 = *(const GAS u32x4*)(gv + (size_t)(i0 + 1) * 256 * 64);
            const bool has2 = i0 + 2 < nt;
            k2 = k1; v2 = v1; if (has2) { k2 = *(const GAS u32x4*)(gk + (size_t)(i0 + 2) * 64 * PROJ_LD); v2 = *(const GAS u32x4*)(gv + (size_t)(i0 + 2) * 256 * 64); }
            if (i0 < nt) {
                *(LAS u32x4*)(kw + (i0 + 0) * SW_KT) = k0; *(LAS u32x2*)(vw + (i0 + 0) * SW_KT) = (u32x2){v0.x, v0.y}; *(LAS u32x2*)(vw + (i0 + 0) * SW_KT + 16) = (u32x2){v0.z, v0.w};
                if (i0 + 1 < nt) { *(LAS u32x4*)(kw + (i0 + 1) * SW_KT) = k1; *(LAS u32x2*)(vw + (i0 + 1) * SW_KT) = (u32x2){v1.x, v1.y}; *(LAS u32x2*)(vw + (i0 + 1) * SW_KT + 16) = (u32x2){v1.z, v1.w}; }
                if (has2) { *(LAS u32x4*)(kw + (i0 + 2) * SW_KT) = k2; *(LAS u32x2*)(vw + (i0 + 2) * SW_KT) = (u32x2){v2.x, v2.y}; *(LAS u32x2*)(vw + (i0 + 2) * SW_KT + 16) = (u32x2){v2.z, v2.w}; }
            }
        }
        if (tid < 64 * nt) *(LAS float*)(lds + SW_P_OFF + 4 * tid) = (float)pos[tl * 64 + tid];
    }
    __syncthreads();
    const float posq = (float)pos[qi];
    int ta = qw >= 127 ? ((qw - 127) >> 6) : 0; if (ta < tl) ta = tl; const int tb = (qw + 31) >> 6;
    const int koff = r * SW_ROW + hh * 16;
    for (int g = 0; g < 3; ++g) {
        const int h = kvh * 3 + g;
        const float slope = __builtin_amdgcn_exp2f(-(float)(h + 1) * (8.0f / 12.0f)) * LOG2E, sinkl = sinks[h] * LOG2E;
        bf16x8 q0f, q1f, q2f, q3f;
        { const GAS bf16_t* qp = proj + (size_t)qi * PROJ_LD + h * 64 + 8 * hh; q0f = *(const GAS bf16x8*)qp; q1f = *(const GAS bf16x8*)(qp + 16); q2f = *(const GAS bf16x8*)(qp + 32); q3f = *(const GAS bf16x8*)(qp + 48); }
        const float crow = slope * posq;
        float m = -1e30f, l = 0.f; f32x16 o0, o1;
#pragma unroll
        for (int i = 0; i < 16; ++i) { o0[i] = 0.f; o1[i] = 0.f; }
        for (int t = ta; t <= tb; ++t) {
            const LAS unsigned char* kb = lds + (t - tl) * SW_KT + koff; const LAS unsigned char* vb = kb + SW_V_OFF; const LAS float* pk = (const LAS float*)(lds + SW_P_OFF + (t - tl) * 256);
            f32x16 s0, s1;
#pragma unroll
            for (int i = 0; i < 16; ++i) { s0[i] = 0.f; s1[i] = 0.f; }
            s0 = __builtin_amdgcn_mfma_f32_32x32x16_bf16(*(const LAS bf16x8*)(kb), q0f, s0, 0, 0, 0); s1 = __builtin_amdgcn_mfma_f32_32x32x16_bf16(*(const LAS bf16x8*)(kb + 32 * SW_ROW), q0f, s1, 0, 0, 0);
            s0 = __builtin_amdgcn_mfma_f32_32x32x16_bf16(*(const LAS bf16x8*)(kb + 32), q1f, s0, 0, 0, 0); s1 = __builtin_amdgcn_mfma_f32_32x32x16_bf16(*(const LAS bf16x8*)(kb + 32 * SW_ROW + 32), q1f, s1, 0, 0, 0);
            s0 = __builtin_amdgcn_mfma_f32_32x32x16_bf16(*(const LAS bf16x8*)(kb + 64), q2f, s0, 0, 0, 0); s1 = __builtin_amdgcn_mfma_f32_32x32x16_bf16(*(const LAS bf16x8*)(kb + 32 * SW_ROW + 64), q2f, s1, 0, 0, 0);
            s0 = __builtin_amdgcn_mfma_f32_32x32x16_bf16(*(const LAS bf16x8*)(kb + 96), q3f, s0, 0, 0, 0); s1 = __builtin_amdgcn_mfma_f32_32x32x16_bf16(*(const LAS bf16x8*)(kb + 32 * SW_ROW + 96), q3f, s1, 0, 0, 0);
            const int key0 = t * 64; float smax = -INFINITY;
#pragma unroll
            for (int i = 0; i < 16; ++i) {
                const int kk = (i & 3) + 8 * (i >> 2) + 4 * hh; const int d0 = qi - (key0 + kk), d1 = d0 - 32;
                float v0 = __builtin_fmaf(slope, pk[kk], s0[i]), v1 = __builtin_fmaf(slope, pk[kk + 32], s1[i]);
                if (d0 < 0 || d0 >= 128) v0 = -INFINITY;
                if (d1 < 0 || d1 >= 128) v1 = -INFINITY;
                s0[i] = v0; s1[i] = v1; smax = fmaxf(smax, fmaxf(v0, v1));
            }
            { const auto rr = __builtin_amdgcn_permlane32_swap(__builtin_bit_cast(unsigned, smax), __builtin_bit_cast(unsigned, smax), false, false);
              smax = fmaxf(__builtin_bit_cast(float, (unsigned)rr[0]), __builtin_bit_cast(float, (unsigned)rr[1])); }
            if (__builtin_amdgcn_ballot_w64(smax - m > RESCALE_THR) != 0ull) {
                const float mn = fmaxf(m, smax), alpha = __builtin_amdgcn_exp2f(m - mn); m = mn; l *= alpha;
#pragma unroll
                for (int i = 0; i < 16; ++i) { o0[i] *= alpha; o1[i] *= alpha; }
            }
            float ls = 0.f; u32x4 w0, w1, w2, w3;
#define SW_P4(S, B, W, D) do { const float p0 = __builtin_amdgcn_exp2f(S[B] - m), p1 = __builtin_amdgcn_exp2f(S[B + 1] - m), p2 = __builtin_amdgcn_exp2f(S[B + 2] - m), p3 = __builtin_amdgcn_exp2f(S[B + 3] - m); \
                ls += p0; ls += p1; ls += p2; ls += p3; W[D] = cvtpk(p0, p1); W[D + 1] = cvtpk(p2, p3); } while (0)
            SW_P4(s0, 0, w0, 0); SW_P4(s0, 4, w0, 2); SW_P4(s0, 8, w1, 0); SW_P4(s0, 12, w1, 2);
            SW_P4(s1, 0, w2, 0); SW_P4(s1, 4, w2, 2); SW_P4(s1, 8, w3, 0); SW_P4(s1, 12, w3, 2);
#undef SW_P4
            l += ls;
            o0 = __builtin_amdgcn_mfma_f32_32x32x16_bf16(*(const LAS bf16x8*)(vb), __builtin_bit_cast(bf16x8, w0), o0, 0, 0, 0); o1 = __builtin_amdgcn_mfma_f32_32x32x16_bf16(*(const LAS bf16x8*)(vb + 32 * SW_ROW), __builtin_bit_cast(bf16x8, w0), o1, 0, 0, 0);
            o0 = __builtin_amdgcn_mfma_f32_32x32x16_bf16(*(const LAS bf16x8*)(vb + 32), __builtin_bit_cast(bf16x8, w1), o0, 0, 0, 0); o1 = __builtin_amdgcn_mfma_f32_32x32x16_bf16(*(const LAS bf16x8*)(vb + 32 * SW_ROW + 32), __builtin_bit_cast(bf16x8, w1), o1, 0, 0, 0);
            o0 = __builtin_amdgcn_mfma_f32_32x32x16_bf16(*(const LAS bf16x8*)(vb + 64), __builtin_bit_cast(bf16x8, w2), o0, 0, 0, 0); o1 = __builtin_amdgcn_mfma_f32_32x32x16_bf16(*(const LAS bf16x8*)(vb + 32 * SW_ROW + 64), __builtin_bit_cast(bf16x8, w2), o1, 0, 0, 0);
            o0 = __builtin_amdgcn_mfma_f32_32x32x16_bf16(*(const LAS bf16x8*)(vb + 96), __builtin_bit_cast(bf16x8, w3), o0, 0, 0, 0); o1 = __builtin_amdgcn_mfma_f32_32x32x16_bf16(*(const LAS bf16x8*)(vb + 32 * SW_ROW + 96), __builtin_bit_cast(bf16x8, w3), o1, 0, 0, 0);
        }
        { const auto rr = __builtin_amdgcn_permlane32_swap(__builtin_bit_cast(unsigned, l), __builtin_bit_cast(unsigned, l), false, false);
          l = __builtin_bit_cast(float, (unsigned)rr[0]) + __builtin_bit_cast(float, (unsigned)rr[1]); }
        l += __builtin_amdgcn_exp2f(sinkl + crow - m);
        const float inv = 1.0f / l;
        GAS bf16_t* op = O + (size_t)qi * 1024 + h * 64 + 4 * hh;
#pragma unroll
        for (int gg = 0; gg < 4; ++gg) {
            u32x2 a, b2;
            a.x = cvtpk(o0[4 * gg + 0] * inv, o0[4 * gg + 1] * inv); a.y = cvtpk(o0[4 * gg + 2] * inv, o0[4 * gg + 3] * inv);
            b2.x = cvtpk(o1[4 * gg + 0] * inv, o1[4 * gg + 1] * inv); b2.y = cvtpk(o1[4 * gg + 2] * inv, o1[4 * gg + 3] * inv);
            *(GAS u32x2*)(op + 8 * gg) = a; *(GAS u32x2*)(op + 32 + 8 * gg) = b2;
        }
    }
    __syncthreads();
}
}

__device__ __forceinline__ int opaque_zero() { int z; asm volatile("v_mov_b32 %0, 0" : "=v"(z)); return __builtin_amdgcn_readfirstlane(z); }
typedef const char __attribute__((address_space(4)))* kargp_t;
__device__ __forceinline__ unsigned long long opaque_u64(unsigned long long v) {
    const int lo_s = (int)(unsigned)v, hi_s = (int)(unsigned)(v >> 32); int lo, hi;
    asm volatile("v_mov_b32 %0, %2\n\tv_mov_b32 %1, %3" : "=&v"(lo), "=&v"(hi) : "s"(lo_s), "s"(hi_s));
    return ((unsigned long long)(unsigned)__builtin_amdgcn_readfirstlane(hi) << 32) | (unsigned long long)(unsigned)__builtin_amdgcn_readfirstlane(lo);
}
__device__ __forceinline__ const void* ld_arg(kargp_t kp, int byte_off) {
    return *(const void* const __attribute__((address_space(4)))*)(kp + byte_off);
}
#define INP(i) ((const float*)ld_arg(kp, 8 * (i)))
#define GB(off) ((GAS bf16_t*)(ws + (off)))
#define GF(off) ((GAS float*)(ws + (off)))
#define x_in INP(0)
#define mem INP(1)
#define positions ((const int*)ld_arg(kp, 16))
#define attn_norm_g INP(3)
#define mlp_norm_g INP(4)
#define mem_norm_g INP(5)
#define final_norm_g INP(6)
#define mla_w_in INP(7)
#define mla_q_norm_g INP(8)
#define mla_kv_norm_g INP(9)
#define mla_w_uq INP(10)
#define mla_w_ukv INP(11)
#define swa_w_in INP(12)
#define swa_sinks INP(13)
#define w_mem_kv INP(14)
#define w_o INP(15)
#define mlp_w_up INP(16)
#define mlp_w_down INP(17)
#define xres ((float*)ld_arg(kp, 144))

constexpr int CONV_LATE_ITEMS = 16 * 32 + 16 * 128 + 64 * 32;
__device__ __forceinline__ int conv_layer_total(int L) { return ((L & 1) == 0 ? (16 * 29 + 6 * 36 + 4 * 24 + 4 * 24) : (16 * 32 + 16 * 8 + 16 * 8)) + 16 * 8 + 16 * 8 + 16 * 32 + 16 * 128 + 64 * 32; }
__device__ __forceinline__ void conv_layer_item(kargp_t kp, unsigned char* wsb, int L, int it, LAS float* scr, int lane) {
    const int j = L >> 1; int r = it;
    const float* ga = attn_norm_g + L * D;
    if ((L & 1) == 0) {
        if (conv_job(r, mla_w_in + (size_t)j * 1024 * 928, 928, 1024, 0, 0, 928, (GAS bf16_t*)(wsb + WO_IN), 0, scr, lane, ga)) return;
        if (conv_job(r, mla_w_uq + (size_t)j * 384 * 1152, 1152, 384, 0, 0, 1152, (GAS bf16_t*)(wsb + WO_UQ), 0, scr, lane, mla_q_norm_g + j * 384)) return;
        if (conv_job(r, mla_w_ukv + (size_t)j * 256 * 1536, 1536, 256, 0, 1, 768, (GAS bf16_t*)(wsb + WO_UK), 0, scr, lane, mla_kv_norm_g + j * 256)) return;
        if (conv_job(r, mla_w_ukv + (size_t)j * 256 * 1536, 1536, 256, 64, 1, 768, (GAS bf16_t*)(wsb + WO_UV), 0, scr, lane, mla_kv_norm_g + j * 256)) return;
    } else {
        if (conv_job(r, swa_w_in + (size_t)j * 1024 * 1536, 1536, 1024, 0, 0, 1024, (GAS bf16_t*)(wsb + WO_IN), 0, scr, lane, ga)) return;
        if (conv_job(r, swa_w_in + (size_t)j * 1024 * 1536, 1536, 1024, 1280, 0, 256, (GAS bf16_t*)(wsb + WO_IN), 1024, scr, lane, ga)) return;
        if (conv_job(r, swa_w_in + (size_t)j * 1024 * 1536, 1536, 1024, 1024, 0, 256, (GAS bf16_t*)(wsb + WO_V), 0, scr, lane, ga)) return;
    }
    if (conv_job(r, w_mem_kv + (size_t)L * 1024 * 512, 512, 1024, 0, 0, 256, (GAS bf16_t*)(wsb + WO_MK), 0, scr, lane, nullptr)) return;
    if (conv_job(r, w_mem_kv + (size_t)L * 1024 * 512, 512, 1024, 256, 0, 256, (GAS bf16_t*)(wsb + WO_MV), 0, scr, lane, nullptr)) return;
    if (conv_job(r, w_o + (size_t)L * 1024 * 1024, 1024, 1024, 0, 0, 1024, (GAS bf16_t*)(wsb + WO_O), 0, scr, lane, nullptr)) return;
    if (conv_job(r, mlp_w_up + (size_t)L * 1024 * 4096, 4096, 1024, 0, 0, 4096, (GAS bf16_t*)(wsb + WO_UP), 0, scr, lane, mlp_norm_g + L * D)) return;
    (void)conv_job(r, mlp_w_down + (size_t)L * 4096 * 1024, 1024, 4096, 0, 0, 1024, (GAS bf16_t*)(wsb + WO_DN), 0, scr, lane, nullptr);
}

struct Args { const void* in[18]; float* out; unsigned char* ws; int ph_lo, ph_hi; };
constexpr int N_PHASES = 24;

__global__ void __launch_bounds__(NWAVES * 64, 2) trunk_fwd(Args args) {
    extern __shared__ __attribute__((aligned(16))) unsigned char lds_raw[];
    LAS unsigned char* lds = (LAS unsigned char*)lds_raw;
    volatile LAS unsigned* MISC = (volatile LAS unsigned*)(lds + MISC_OFF);
    unsigned* ctl = (unsigned*)(args.ws + WS_CTL);
    const int wave0 = __builtin_amdgcn_readfirstlane(threadIdx.x >> 6);
    for (int u = threadIdx.x; u < (LDS_BYTES - LDSCTL_OFF) / 4; u += NWAVES * 64) ((LAS unsigned*)(lds + LDSCTL_OFF))[u] = 0u;
    __syncthreads();
    unsigned bar_x = 0; (void)bar_x;
#if !MK_PER_PHASE_LAUNCH
    { XcdBarrier b0_ = xcd_barrier_post(ctl + CW_BAR, MISC + 8); bar_x = b0_.x; }
#endif
    const int lo = args.ph_lo, hi = args.ph_hi;
    int ph = 0;

#define PHASE_BEGIN if (ph >= lo && ph < hi) { const int zz = opaque_zero(); unsigned char* ws = (unsigned char*)opaque_u64((unsigned long long)args.ws); \
        kargp_t kp = (kargp_t)opaque_u64((unsigned long long)__builtin_amdgcn_kernarg_segment_ptr()); (void)kp; \
        const int tid = wave0 * 64 + lane_id_opaque(); \
        const int G = (int)gridDim.x + zz, bx = (int)blockIdx.x + zz, vcu = (G % 8 == 0) ? (bx % 8) * (G / 8) + bx / 8 : bx, NGW = G * NWAVES; (void)NGW; const int lane = tid & 63, wave = __builtin_amdgcn_readfirstlane(tid >> 6); \
        const int gw = vcu * NWAVES + wave; LAS float* scr = (LAS float*)(lds + wave * 16384); (void)ws; (void)lane; (void)gw; (void)scr;
#if MK_PER_PHASE_LAUNCH
#define PHASE_END } ++ph;
#else
#define PHASE_END if (ph + 1 < hi) { XcdBarrier b_; b_.bar = (unsigned*)ws + CW_BAR; b_.x = bar_x + (unsigned)zz; b_.st = MISC + 8; xcd_barrier(b_); } } ++ph;
#endif
#define GEMM_RUN(EPI, ...) do { pg8::StaticOrder So; So.init(g.M, g.N, G, bx, rot); EPI E{__VA_ARGS__}; pg8::gemm_phase(lds, g, So, E, wave0); rot += (g.M / 256) * (g.N / 256); } while (0)

    PHASE_BEGIN
        for (int i = bx * (NWAVES * 64) + tid; i < T * 16; i += G * NWAVES * 64) {
            const int t = i >> 4, f = i & 15; const float ang = (float)positions[t] * rope_inv[f];
            float sn, cs; sincos_acc(ang, sn, cs); GF(WS_COS)[i] = cs; GF(WS_SIN)[i] = sn;
        }
        for (int rr = gw; rr < NB * NMEM; rr += NGW) rms_row_bf16(mem + (size_t)rr * D, mem_norm_g, GB(WS_MEMN) + (size_t)rr * D, lane);
        { const int total = conv_layer_total(0) - CONV_LATE_ITEMS; for (int it = gw; it < total; it += NGW) conv_layer_item(kp, ws + WS_WSET, 0, it, scr, lane); }
        for (int rr = gw; rr < T; rr += NGW) copy_row_bf16_ssq(x_in + (size_t)rr * D, GB(WS_XB) + (size_t)rr * D, GF(WS_SSQ) + (size_t)rr * 16, lane);
    PHASE_END

    for (int L = 0; L < DEPTH; ++L) {
        const bool mla = (L & 1) == 0; const int j = L >> 1;
        PHASE_BEGIN
            unsigned char* wsb = ws + WS_WSET + (size_t)(L & 1) * WSET_BYTES; int rot = 0;
            if (mla) {
                pg8::Gemm g{GB(WS_XB), (GAS bf16_t*)(wsb + WO_IN), T, 1024, 1024, 1024, 1024};
                GEMM_RUN(pg8::EpiProjMla, GB(WS_PROJ), PROJ_LD, GF(WS_SSQ), GF(WS_SSQ32), GF(WS_COS), GF(WS_SIN));
            } else {
                { pg8::Gemm g{GB(WS_XB), (GAS bf16_t*)(wsb + WO_IN), T, 1280, 1024, 1024, 1024}; using E_ = pg8::EpiBf16<0, 1, 0, false, true>; GEMM_RUN(E_, GB(WS_PROJ), PROJ_LD, GF(WS_SSQ)); }
                { pg8::Gemm g{(GAS bf16_t*)(wsb + WO_V), GB(WS_XB), 256, T, 1024, 1024, 1024}; using E_ = pg8::EpiBf16<0, 2, 0, true>; GEMM_RUN(E_, GB(WS_VT), 256, GF(WS_SSQ)); }
                { pg8::Gemm g{GB(WS_MEMN), (GAS bf16_t*)(wsb + WO_MK), 1024, 256, 1024, 1024, 1024}; using E_ = pg8::EpiBf16<0, 0, 0>; GEMM_RUN(E_, GB(WS_MEMK), 256, nullptr); }
                { pg8::Gemm g{(GAS bf16_t*)(wsb + WO_MV), GB(WS_MEMN), 256, 1024, 1024, 1024, 1024}; using E_ = pg8::EpiBf16<0, 0, 0, true>; GEMM_RUN(E_, GB(WS_MEMVT), 256, nullptr); }
            }
        PHASE_END
        if (mla) {
            PHASE_BEGIN
                unsigned char* wsb = ws + WS_WSET + (size_t)(L & 1) * WSET_BYTES; int rot = 0;
                const int G_all = G, bx_all = bx, n_memb = G_all >= 64 ? 8 : 0;
                if (bx_all >= n_memb) {
                    const int G = G_all - n_memb, bx = bx_all - n_memb;
                    { pg8::Gemm g{GB(WS_PROJ), (GAS bf16_t*)(wsb + WO_UQ), T, 1280, 384, PROJ_LD, 384}; GEMM_RUN(pg8::EpiRope, GB(WS_Q), QLD, GF(WS_COS), GF(WS_SIN), GF(WS_SSQ32)); }
                    { pg8::Gemm g{GB(WS_PROJ) + 384, (GAS bf16_t*)(wsb + WO_UK), T, 768, 256, PROJ_LD, 256}; using E_ = pg8::EpiBf16<0, 1, 2>; GEMM_RUN(E_, GB(WS_KN), 768, GF(WS_SSQ32)); }
                    { pg8::Gemm g{(GAS bf16_t*)(wsb + WO_UV), GB(WS_PROJ) + 384, 768, T, 256, 256, PROJ_LD}; using E_ = pg8::EpiBf16<0, 2, 2, true>; GEMM_RUN(E_, GB(WS_VT), 768, GF(WS_SSQ32)); }
                }
                if (bx_all < n_memb || n_memb == 0) {
                    const int G = n_memb ? n_memb : G_all, bx = bx_all; int rot = 0;
                    { pg8::Gemm g{GB(WS_MEMN), (GAS bf16_t*)(wsb + WO_MK), 1024, 256, 1024, 1024, 1024}; using E_ = pg8::EpiBf16<0, 0, 0>; GEMM_RUN(E_, GB(WS_MEMK), 256, nullptr); }
                    { pg8::Gemm g{(GAS bf16_t*)(wsb + WO_MV), GB(WS_MEMN), 256, 1024, 1024, 1024, 1024}; using E_ = pg8::EpiBf16<0, 0, 0, true>; GEMM_RUN(E_, GB(WS_MEMVT), 256, nullptr); }
                }
            PHASE_END
        }
        PHASE_BEGIN
            {
            unsigned* qctr = (unsigned*)ws + CW_ATTQ + 64 * L;
            volatile LAS int* slot = (volatile LAS int*)(MISC + 16);
            const int conv_extra = (L == 0) ? CONV_LATE_ITEMS : 0;
            const int conv_total = conv_extra + ((L + 1 < DEPTH) ? conv_layer_total(L + 1) : 0);
            const int n_mix = mla ? 768 : 256, u_conv = n_mix + 256, n_units = u_conv + (conv_total + 31) / 32;
            const int NQ = (mla && (G % 8 == 0)) ? 8 : 1, n_loc = mla ? 768 / NQ : 0, myq = bx % NQ;
            unsigned* qloc = qctr + 1 + myq; int loc_live = n_loc;
#define ATT_FETCH(dst) do { int f_ = -1; if (loc_live) { const unsigned v_ = __hip_atomic_fetch_add(qloc, 1u, __ATOMIC_RELAXED, __HIP_MEMORY_SCOPE_AGENT); if ((int)v_ < n_loc) f_ = myq * n_loc + (int)v_; else loc_live = 0; } \
                if (f_ < 0) f_ = (mla ? 768 : 0) + (int)__hip_atomic_fetch_add(qctr, 1u, __ATOMIC_RELAXED, __HIP_MEMORY_SCOPE_AGENT); dst = f_; } while (0)
            if (tid == 0) { int f0_; ATT_FETCH(f0_); slot[0] = f0_; }
            __syncthreads();
            for (;;) {
                const int u = __builtin_amdgcn_readfirstlane(slot[0]);
                __syncthreads();
                if (u >= n_units) break;
                int nxt = 0; if (tid == 0) ATT_FETCH(nxt);
                int tid_u = tid; asm volatile("" : "+v"(tid_u));
                const GAS bf16_t* gPROJ = GB(WS_PROJ); GAS bf16_t* gATT = GB(WS_ATT); const GAS bf16_t* gVT = GB(WS_VT);
                if (u < n_mix) {
                    if (mla) {
                        const int qq = u / n_loc, qi_ = u % n_loc, per_q = 48 / NQ; const int qb = 15 - qi_ / per_q, bh = (qi_ % per_q) * NQ + qq, b = bh / 12, h = bh % 12; const int q0 = qb * 256; const size_t rb = (size_t)b * S;
                        att::attn_unit<96, 0>(lds, GB(WS_Q) + rb * QLD + h * 96, QLD, GB(WS_KN) + rb * 768 + h * 64, 768, gPROJ + rb * PROJ_LD + 640, PROJ_LD, gVT + ((size_t)(b * 64) * 768 + h * 64) * 64, 768,
                                              gATT + rb * 1024 + h * 64, 1024, q0, 0, (q0 + 256) / 64, tid_u);
                    } else {
                        const int qb = 15 - u / 16, bk = u % 16, b = bk / 4, kvh = bk % 4; const int q0 = qb * 256; const size_t rb = (size_t)b * S;
                        att::swa_unit(lds, gPROJ + rb * PROJ_LD, gVT + ((size_t)(b * 64) * 256 + kvh * 64) * 64, gATT + rb * 1024, kvh, q0, swa_sinks + j * 12, (const GAS int*)positions + rb, tid_u);
                    }
                } else if (u < u_conv) {
                    const int v = u - n_mix, qb = v / 16, bh = v % 16, b = bh / 4, hc = bh % 4; const int q0 = qb * 256; const size_t rb = (size_t)b * S;
                    const int qc_off = mla ? 672 : 1024;
                    att::attn_unit<64, 2>(lds, gPROJ + rb * PROJ_LD + qc_off + hc * 64, PROJ_LD, GB(WS_MEMK) + (size_t)(b * NMEM) * 256 + hc * 64, 256, nullptr, 0, GB(WS_MEMVT) + ((size_t)(b * 4) * 256 + hc * 64) * 64, 256,
                                          gATT + rb * 1024 + 768 + hc * 64, 1024, q0, zz, NMEM / 64 + zz, tid_u);
                } else {
                    unsigned char* wsn = (unsigned char*)opaque_u64((unsigned long long)(ws + WS_WSET + (size_t)((L + 1) & 1) * WSET_BYTES));
                    kargp_t kp_u = (kargp_t)opaque_u64((unsigned long long)kp);
                    const int lane_u = tid_u & 63, wave_u = __builtin_amdgcn_readfirstlane(tid_u >> 6); LAS float* scr_u = (LAS float*)(lds + wave_u * 16384);
                    for (int k = 0; k < 4; ++k) { const int it = (u - u_conv) * 32 + wave_u * 4 + k;
                        if (it < conv_extra) { unsigned char* ws0 = (unsigned char*)opaque_u64((unsigned long long)(ws + WS_WSET)); conv_layer_item(kp_u, ws0, 0, conv_layer_total(0) - CONV_LATE_ITEMS + it, scr_u, lane_u); }
                        else if (it < conv_total) conv_layer_item(kp_u, wsn, L + 1, it - conv_extra, scr_u, lane_u); }
                }
                if (tid == 0) slot[0] = nxt;
                __syncthreads();
            }
#undef ATT_FETCH
            }
        PHASE_END
        PHASE_BEGIN
            unsigned char* wsb = ws + WS_WSET + (size_t)(L & 1) * WSET_BYTES; int rot = 0;
            { pg8::Gemm g{GB(WS_ATT), (GAS bf16_t*)(wsb + WO_O), T, 1024, 1024, 1024, 1024};
              GEMM_RUN(pg8::EpiResNorm<false>, GB(WS_XB), GF(WS_SSQA), nullptr, D); }
        PHASE_END
        PHASE_BEGIN
            unsigned char* wsb = ws + WS_WSET + (size_t)(L & 1) * WSET_BYTES; int rot = 0;
            { pg8::Gemm g{GB(WS_XB), (GAS bf16_t*)(wsb + WO_UP), T, FF, 1024, 1024, 1024}; using E_ = pg8::EpiBf16<1, 0, 0>; GEMM_RUN(E_, GB(WS_ABUF), FF, nullptr); }
        PHASE_END
        PHASE_BEGIN
            unsigned char* wsb = ws + WS_WSET + (size_t)(L & 1) * WSET_BYTES; int rot = 0;
            { pg8::Gemm g{GB(WS_ABUF), (GAS bf16_t*)(wsb + WO_DN), T, 1024, FF, FF, FF};
              GEMM_RUN(pg8::EpiResNorm<true>, GB(WS_XB), GF(WS_SSQ), GF(WS_SSQA), D); }
        PHASE_END
    }
    PHASE_BEGIN
        for (int rr = gw; rr < T; rr += NGW) rms_row_out(GB(WS_XB) + (size_t)rr * D, final_norm_g, xres + (size_t)rr * D, lane);
    PHASE_END
#undef PHASE_BEGIN
#undef PHASE_END
}

extern "C" void kernel_launch(void* const* d_in, const int* in_sizes, int n_in, void* d_out, int out_size, void* d_ws, size_t ws_size, hipStream_t stream) {
    static int grid = 0;
    if (grid == 0) {
        if (n_in != 18 || out_size != T * D || ws_size < WS_END) { fprintf(stderr, "kernel_launch: unexpected shapes (n_in %d out %d ws %zu)\n", n_in, out_size, ws_size); grid = -1; return; }
        int dev = 0, cus = 0, per_cu = 0;
        if (hipGetDevice(&dev) != hipSuccess || hipDeviceGetAttribute(&cus, hipDeviceAttributeMultiprocessorCount, dev) != hipSuccess) { grid = -1; return; }
        if (hipFuncSetAttribute((const void*)trunk_fwd, hipFuncAttributeMaxDynamicSharedMemorySize, LDS_BYTES) != hipSuccess) { fprintf(stderr, "kernel_launch: hipFuncSetAttribute failed\n"); grid = -1; return; }
        if (hipOccupancyMaxActiveBlocksPerMultiprocessor(&per_cu, (const void*)trunk_fwd, NWAVES * 64, LDS_BYTES) != hipSuccess || per_cu < 1)
            fprintf(stderr, "kernel_launch: occupancy query reports %d blocks per CU\n", per_cu);
        (void)hipGetLastError();
        grid = cus;
    }
    if (grid < 0) return;
    (void)hipMemsetAsync((char*)d_ws + WS_CTL, 0, CTL_ZERO_BYTES, stream);
    Args a{};
    for (int i = 0; i < 18; ++i) a.in[i] = d_in[i];
    a.out = (float*)d_out; a.ws = (unsigned char*)d_ws;
#if MK_PER_PHASE_LAUNCH
    for (int p = 0; p < N_PHASES; ++p) { a.ph_lo = p; a.ph_hi = p + 1; hipLaunchKernelGGL(trunk_fwd, dim3(grid), dim3(NWAVES * 64), LDS_BYTES, stream, a); }
#else
    a.ph_lo = 0; a.ph_hi = N_PHASES;
    hipLaunchKernelGGL(trunk_fwd, dim3(grid), dim3(NWAVES * 64), LDS_BYTES, stream, a);
#endif
}
```
